# Optimizing an MI355X kernel written in HIP

```python
import math
import jax
import jax.numpy as jnp
from jax import lax
import numpy as np

D_MODEL = 1024
BATCH = 8
SEQ = 2048
DEPTH = 4

HEAD_DIM = 64
DIFF_W = (D_MODEL * 3 // 8)
DELTA_W = (D_MODEL * 3 // 8)
CONV_CH = D_MODEL - DIFF_W - DELTA_W
DIFF_HEADS = DIFF_W // HEAD_DIM
DIFF_DIM = HEAD_DIM // 2
DELTA_HEADS = DELTA_W // HEAD_DIM
CONV_WIDTH = 31
SHORT_CONV = 3
CHUNK = 64
Q_BLOCK = 128
D_FF = 4 * D_MODEL
IN_W = 2 * CONV_CH + 3 * DIFF_W + 4 * DELTA_W + 4 * DELTA_HEADS
NORM_EPS = 1e-6

kernel_name = "hybrid_conv_diffattn_gdn_encoder"


def rms_norm(x, w, eps=NORM_EPS):
    xf = x.astype(jnp.float32)
    y = xf * lax.rsqrt(jnp.mean(xf * xf, axis=-1, keepdims=True) + eps)
    return (y * w.astype(jnp.float32)).astype(x.dtype)


def layer_norm(x, w, b, eps=1e-5):
    xf = x.astype(jnp.float32)
    mu = jnp.mean(xf, axis=-1, keepdims=True)
    xc = xf - mu
    var = jnp.mean(xc * xc, axis=-1, keepdims=True)
    y = xc * lax.rsqrt(var + eps) * w.astype(jnp.float32) + b.astype(jnp.float32)
    return y.astype(x.dtype)


def l2norm(x, eps=1e-6):
    xf = x.astype(jnp.float32)
    return xf * lax.rsqrt(jnp.sum(xf * xf, axis=-1, keepdims=True) + eps)


def depthwise_conv(x, w):
    k, c = w.shape
    pad = (k - 1) // 2
    return lax.conv_general_dilated(
        x, w[:, None, :].astype(x.dtype), window_strides=(1,), padding=[(pad, pad)],
        dimension_numbers=("NWC", "WIO", "NWC"), feature_group_count=c)


def alibi_slopes(n):
    def pow2(m):
        start = 2.0 ** (-8.0 / m)
        return [start ** (i + 1) for i in range(m)]
    if math.log2(n).is_integer():
        s = pow2(n)
    else:
        c = 2 ** int(math.floor(math.log2(n)))
        s = pow2(c) + pow2(2 * c)[0::2][: n - c]
    return jnp.asarray(s, dtype=jnp.float32)


def conv_module(u, dw_w, dw_b, ln_w, ln_b):
    a, g = jnp.split(u, 2, axis=-1)
    h = a * jax.nn.sigmoid(g)
    h = depthwise_conv(h, dw_w) + dw_b.astype(h.dtype)
    h = layer_norm(h, ln_w, ln_b)
    return jax.nn.silu(h)


def diff_attention(q, k, v, lam_q1, lam_k1, lam_q2, lam_k2, subln_w, layer_idx):
    B, S = q.shape[0], q.shape[1]
    H = DIFF_HEADS
    f32 = jnp.float32
    lambda_init = 0.8 - 0.6 * math.exp(-0.3 * layer_idx)
    lam = (jnp.exp(jnp.sum(lam_q1.astype(f32) * lam_k1.astype(f32)))
           - jnp.exp(jnp.sum(lam_q2.astype(f32) * lam_k2.astype(f32))) + lambda_init)
    slopes = jnp.repeat(alibi_slopes(H), 2)
    n_blk = S // Q_BLOCK
    qf = q.astype(f32).reshape(B, n_blk, Q_BLOCK, 2 * H, DIFF_DIM) * (DIFF_DIM ** -0.5)
    qf = jnp.moveaxis(qf, 1, 0)
    kf = k.astype(f32).reshape(B, S, 2 * H, DIFF_DIM)
    vf = v.astype(f32).reshape(B, S, H, HEAD_DIM)
    kpos = jnp.arange(S)

    def block(args):
        q_blk, blk = args
        s = jnp.einsum("bqmd,bkmd->bmqk", q_blk, kf)
        qpos = blk * Q_BLOCK + jnp.arange(Q_BLOCK)
        dist = jnp.abs(qpos[:, None] - kpos[None, :]).astype(f32)
        p = jax.nn.softmax(s - slopes[:, None, None] * dist, axis=-1)
        p = p.reshape(B, H, 2, Q_BLOCK, S)
        a = p[:, :, 0] - lam * p[:, :, 1]
        return jnp.einsum("bhqk,bkhe->bqhe", a, vf)

    o = lax.map(block, (qf, jnp.arange(n_blk)))
    o = jnp.moveaxis(o, 0, 1).reshape(B, S, H, HEAD_DIM)
    o = rms_norm(o, subln_w, eps=1e-5) * (1.0 - lambda_init)
    return o.reshape(B, S, H * HEAD_DIM).astype(q.dtype)


def chunk_gated_delta(q, k, v, g, beta):
    B, S, H, Dk = q.shape
    Dv = v.shape[-1]
    N = S // CHUNK
    q = q * (Dk ** -0.5)

    def chunks(t):
        return t.reshape(B, N, CHUNK, H, -1).transpose(0, 3, 1, 2, 4)

    qc, kc, vc = chunks(q), chunks(k), chunks(v)
    gc = jnp.cumsum(g.reshape(B, N, CHUNK, H).transpose(0, 3, 1, 2), axis=-1)
    bc = beta.reshape(B, N, CHUNK, H).transpose(0, 3, 1, 2)
    idx = jnp.arange(CHUNK)
    lower = idx[:, None] >= idx[None, :]
    strict = idx[:, None] > idx[None, :]
    decay = jnp.exp(jnp.where(lower, gc[..., :, None] - gc[..., None, :], -jnp.inf))
    kb = kc * bc[..., None]
    A = jnp.where(strict, jnp.einsum("bhncd,bhnsd->bhncs", kb, kc) * decay, 0.0)
    rhs = jnp.concatenate([vc * bc[..., None], kb * jnp.exp(gc)[..., None]], axis=-1)
    sol = lax.linalg.triangular_solve(A, rhs, left_side=True, lower=True, unit_diagonal=True)
    u, w = sol[..., :Dv], sol[..., Dv:]
    Aqk = jnp.einsum("bhncd,bhnsd->bhncs", qc, kc) * decay
    qg = qc * jnp.exp(gc)[..., None]
    kdec = kc * jnp.exp(gc[..., -1:] - gc)[..., None]
    glast = jnp.exp(gc[..., -1])

    def step(state, inp):
        u_i, w_i, qg_i, aqk_i, kdec_i, gl_i = inp
        v_new = u_i - jnp.einsum("bhcd,bhde->bhce", w_i, state)
        o = jnp.einsum("bhcd,bhde->bhce", qg_i, state) + jnp.einsum("bhcs,bhse->bhce", aqk_i, v_new)
        state = state * gl_i[..., None, None] + jnp.einsum("bhcd,bhce->bhde", kdec_i, v_new)
        return state, o

    xs = tuple(jnp.moveaxis(t, 2, 0) for t in (u, w, qg, Aqk, kdec, glast))
    s0 = jnp.zeros((B, H, Dk, Dv), jnp.float32)
    _, o = lax.scan(step, s0, xs)
    return o.transpose(1, 0, 3, 2, 4).reshape(B, S, H, Dv)


def gated_deltanet(qkv, z, b_f, b_b, a_f, a_b, conv_w, A_log, dt_bias, norm_w):
    B, S, _ = qkv.shape
    H, D = DELTA_HEADS, HEAD_DIM
    f32 = jnp.float32
    out_dtype = qkv.dtype
    qkv = jax.nn.silu(depthwise_conv(qkv, conv_w))
    q, k, v = jnp.split(qkv, 3, axis=-1)
    q = l2norm(q.reshape(B, S, H, D))
    k = l2norm(k.reshape(B, S, H, D))
    v = v.reshape(B, S, H, D).astype(f32)

    def log_decay(a, a_log, dtb):
        return -jnp.exp(a_log.astype(f32)) * jax.nn.softplus(a.astype(f32) + dtb.astype(f32))

    g_f = log_decay(a_f, A_log[0], dt_bias[0])
    g_b = log_decay(a_b, A_log[1], dt_bias[1])
    beta_f = jax.nn.sigmoid(b_f.astype(f32))
    beta_b = jax.nn.sigmoid(b_b.astype(f32))
    o_f = chunk_gated_delta(q, k, v, g_f, beta_f)
    rev = lambda t: jnp.flip(t, axis=1)
    o_b = rev(chunk_gated_delta(rev(q), rev(k), rev(v), rev(g_b), rev(beta_b)))
    o = rms_norm(o_f + o_b, norm_w) * jax.nn.silu(z.astype(f32).reshape(B, S, H, D))
    return o.reshape(B, S, H * D).astype(out_dtype)


def setup_inputs(seed: int = 0) -> dict:
    key = jax.random.key(seed)
    ks = jax.random.split(key, 24)
    f32 = jnp.float32
    nrm = lambda k, shape, scale: jax.random.normal(k, shape, f32) * scale
    gain = lambda k, shape: 1.0 + 0.05 * jax.random.normal(k, shape, f32)
    dt = jnp.exp(jax.random.uniform(ks[20], (DEPTH, 2, DELTA_HEADS), f32, math.log(1e-3), math.log(1e-1)))
    return {
        "x": nrm(ks[0], (BATCH, SEQ, D_MODEL), 1.0),
        "w_in": nrm(ks[1], (DEPTH, D_MODEL, IN_W), D_MODEL ** -0.5),
        "w_out": nrm(ks[2], (DEPTH, D_MODEL, D_MODEL), D_MODEL ** -0.5),
        "pre_mix_w": gain(ks[3], (DEPTH, D_MODEL)),
        "post_mix_w": gain(ks[4], (DEPTH, D_MODEL)),
        "pre_mlp_w": gain(ks[5], (DEPTH, D_MODEL)),
        "post_mlp_w": gain(ks[6], (DEPTH, D_MODEL)),
        "w_ff1": nrm(ks[7], (DEPTH, D_MODEL, D_FF), D_MODEL ** -0.5),
        "w_ff2": nrm(ks[8], (DEPTH, D_FF, D_MODEL), D_FF ** -0.5),
        "conv_dw_w": nrm(ks[9], (DEPTH, CONV_WIDTH, CONV_CH), CONV_WIDTH ** -0.5),
        "conv_dw_b": nrm(ks[10], (DEPTH, CONV_CH), 0.02),
        "conv_ln_w": gain(ks[11], (DEPTH, CONV_CH)),
        "conv_ln_b": nrm(ks[12], (DEPTH, CONV_CH), 0.02),
        "diff_lambda_q1": nrm(ks[13], (DEPTH, DIFF_DIM), 0.1),
        "diff_lambda_k1": nrm(ks[14], (DEPTH, DIFF_DIM), 0.1),
        "diff_lambda_q2": nrm(ks[15], (DEPTH, DIFF_DIM), 0.1),
        "diff_lambda_k2": nrm(ks[16], (DEPTH, DIFF_DIM), 0.1),
        "diff_subln_w": gain(ks[17], (DEPTH, HEAD_DIM)),
        "delta_conv_w": nrm(ks[18], (DEPTH, SHORT_CONV, 3 * DELTA_W), SHORT_CONV ** -0.5),
        "delta_A_log": jnp.log(jax.random.uniform(ks[19], (DEPTH, 2, DELTA_HEADS), f32, 1.0, 16.0)),
        "delta_dt_bias": dt + jnp.log(-jnp.expm1(-dt)),
        "delta_norm_w": gain(ks[21], (DEPTH, HEAD_DIM)),
    }


def reference(x, w_in, w_out, pre_mix_w, post_mix_w, pre_mlp_w, post_mlp_w, w_ff1, w_ff2,
              conv_dw_w, conv_dw_b, conv_ln_w, conv_ln_b,
              diff_lambda_q1, diff_lambda_k1, diff_lambda_q2, diff_lambda_k2, diff_subln_w,
              delta_conv_w, delta_A_log, delta_dt_bias, delta_norm_w):
    sizes = [2 * CONV_CH, DIFF_W, DIFF_W, DIFF_W, 3 * DELTA_W, DELTA_W,
             DELTA_HEADS, DELTA_HEADS, DELTA_HEADS, DELTA_HEADS]
    offs = [sum(sizes[: i + 1]) for i in range(len(sizes) - 1)]
    for l in range(DEPTH):
        h = rms_norm(x, pre_mix_w[l])
        u = h @ w_in[l]
        (u_conv, dq, dk, dv, gqkv, gz, b_f, b_b, a_f, a_b) = jnp.split(u, offs, axis=-1)
        y_conv = conv_module(u_conv, conv_dw_w[l], conv_dw_b[l], conv_ln_w[l], conv_ln_b[l])
        y_diff = diff_attention(dq, dk, dv, diff_lambda_q1[l], diff_lambda_k1[l],
                                diff_lambda_q2[l], diff_lambda_k2[l], diff_subln_w[l], l)
        y_delta = gated_deltanet(gqkv, gz, b_f, b_b, a_f, a_b, delta_conv_w[l],
                                 delta_A_log[l], delta_dt_bias[l], delta_norm_w[l])
        y = jnp.concatenate([y_conv, y_diff, y_delta], axis=-1) @ w_out[l]
        x = x + rms_norm(y, post_mix_w[l])
        h = rms_norm(x, pre_mlp_w[l])
        y = jnp.square(jax.nn.relu(h @ w_ff1[l])) @ w_ff2[l]
        x = x + rms_norm(y, post_mlp_w[l])
    return x
```

```cpp
#include <hip/hip_runtime.h>
#include <hip/hip_cooperative_groups.h>
#include <cstdio>
#include <cstdint>
namespace cg = cooperative_groups;
#ifndef MK_SINGLE
#define MK_SINGLE 1
#endif
#ifndef USE_PG8
#define USE_PG8 1
#endif
namespace pg8 {
#define PG8_LAS __attribute__((address_space(3)))
typedef unsigned short bf16_t;
typedef short bf16x8 __attribute__((ext_vector_type(8)));
typedef float f32x4 __attribute__((ext_vector_type(4)));
typedef unsigned u32x4 __attribute__((ext_vector_type(4)));
constexpr int BM = 256, BK = 64, HALF = 128, HTB = HALF * BK * 2  , STAGE_BYTES = 8 * HTB, NXCD = 8, WGM = 8;

__host__ __device__ __forceinline__ int lds_byte(int r, int c) { const int st = (r >> 4) * 2 + (c >> 5), rr = r & 15, cc = c & 31, ob = rr * 64 + cc * 2; return st * 1024 + (ob ^ (((ob >> 9) & 1) << 5)); }
__host__ __device__ __forceinline__ void stage_rc(int b, int& R, int& C) { const int st = b / 1024, sb = b % 1024, swz = sb ^ (((sb >> 9) & 1) << 5); R = (st >> 1) * 16 + swz / 64; C = (st & 1) * 32 + (swz % 64) / 2; }
__host__ __device__ __forceinline__ int perm32(int rho) { const int n = rho >> 4, i = rho & 15; return 8 * (i >> 2) + 4 * n + (i & 3); }

struct Unit { int pm, pn; };
struct Gemm { const bf16_t* A; const bf16_t* Bt; int M, N, K; };

struct StaticOrder {
    int nM, nN, nwg, G, c;
    __host__ __device__ void init(int M, int N, int G_, int c_) { nM = M / BM; nN = N / BM; nwg = nM * nN; G = G_; c = c_; }
    __host__ __device__ bool next(int i, Unit& u) const {
        const long L = (long)i * G + c; if (L >= nwg) return false;
        int wgid = (int)L; { const int q = nwg / NXCD, r = nwg % NXCD, xcd = wgid % NXCD, off = wgid / NXCD; wgid = (xcd < r ? xcd * (q + 1) : r * (q + 1) + (xcd - r) * q) + off; }
        const int nig = WGM * nN, gid = wgid / nig, fm = gid * WGM, gsz = (nM - fm) < WGM ? (nM - fm) : WGM;
        u.pm = fm + ((wgid % nig) % gsz); u.pn = (wgid % nig) / gsz; return true;
    }
    __device__ __forceinline__ void a_ready(const Unit&) const {}
    __device__ __forceinline__ void done(const Unit&) const {}
};

__device__ __forceinline__ unsigned cvt_pk_bf16(float lo, float hi) { unsigned r; asm volatile("v_cvt_pk_bf16_f32 %0, %1, %2" : "=v"(r) : "v"(lo), "v"(hi)); return r; }
typedef float f32x2 __attribute__((ext_vector_type(2)));
template <int ACT> struct EpiBf16 {
    static constexpr bool PERM = true, AFTER_DRAIN = false;
    bf16_t* O; int ldc;
    __device__ __forceinline__ void operator()(const f32x4 (&acc)[2][2][4][2], const Unit& u, int wr, int wc, int fr, int fq) const {
        const int row0 = u.pm * BM + wr * 64 + fr; const int col0 = u.pn * BM + wc * 32 + 8 * fq;
#pragma unroll
        for (int ai = 0; ai < 2; ++ai)
#pragma unroll
            for (int m = 0; m < 4; ++m) { bf16_t* rowp = O + (size_t)(row0 + ai * HALF + m * 16) * ldc + col0;
#pragma unroll
                for (int bj = 0; bj < 2; ++bj) { f32x4 v0 = acc[ai][bj][m][0], v1 = acc[ai][bj][m][1];
                    if (ACT == 1) {
#pragma unroll
                        for (int j = 0; j < 4; ++j) { const float a = fmaxf(v0[j], 0.f), b = fmaxf(v1[j], 0.f); v0[j] = a * a; v1[j] = b * b; } }
                    u32x4 w; w.x = cvt_pk_bf16(v0[0], v0[1]); w.y = cvt_pk_bf16(v0[2], v0[3]); w.z = cvt_pk_bf16(v1[0], v1[1]); w.w = cvt_pk_bf16(v1[2], v1[3]);
                    *(u32x4*)(rowp + bj * HALF) = w; } }
    }
};
struct EpiF32 {
    static constexpr bool PERM = false, AFTER_DRAIN = false;
    float* C; int ldc;
    __device__ __forceinline__ void operator()(const f32x4 (&acc)[2][2][4][2], const Unit& u, int wr, int wc, int fr, int fq) const {
        const int row0 = u.pm * BM + wr * 64 + fr, col0 = u.pn * BM + wc * 32 + 4 * fq;
#pragma unroll
        for (int ai = 0; ai < 2; ++ai)
#pragma unroll
            for (int m = 0; m < 4; ++m) { float* rowp = C + (size_t)(row0 + ai * HALF + m * 16) * ldc + col0;
#pragma unroll
                for (int bj = 0; bj < 2; ++bj)
#pragma unroll
                    for (int n = 0; n < 2; ++n) *(f32x4*)(rowp + bj * HALF + n * 16) = acc[ai][bj][m][n]; }
    }
};
template <class Epi, class Sched, bool ALIGN_EPI = false, bool SP2 = false>
__device__ __forceinline__ void gemm_phase(PG8_LAS unsigned char* lds, const Gemm g, const Sched& S, const Epi& E) {
    int tid_ = threadIdx.x; asm volatile("" : "+v"(tid_));
    const int tid = tid_, wid = __builtin_amdgcn_readfirstlane(tid >> 6), lane = tid & 63, wr = wid >> 2, wc = wid & 3, fr = lane & 15, fq = lane >> 4;
    const int K = g.K, nt = K / BK;
    unsigned voffA[2], voffB[2];
#pragma unroll
    for (int i = 0; i < 2; ++i) { int R, C; stage_rc(tid * 16 + i * 8192, R, C); const int Rb = Epi::PERM ? ((R & ~31) + perm32(R & 31)) : R;
        voffA[i] = (unsigned)(R * K + C) * 2u; voffB[i] = (unsigned)(Rb * K + C) * 2u; }
    const size_t kstep = (size_t)(BK * 2);
    const size_t hstep = (size_t)HALF * K * 2;
    const size_t tstep = 2 * hstep;
    const unsigned ldsw = (unsigned)wid * 1024u;
    const int aoff = lds_byte(wr * 64 + fr, fq * 8), boff = lds_byte(wc * 32 + fr, fq * 8);
#define PG8_SA(b, h) (((b) * 2 + (h)) * HTB)
#define PG8_SB(b, h) ((4 + (b) * 2 + (h)) * HTB)
#define PG8_STAGE(bufoff, gbase, voff) do { _Pragma("unroll") for (int _i = 0; _i < 2; ++_i) \
        __builtin_amdgcn_global_load_lds((const unsigned*)((const char*)(gbase) + (voff)[_i]), (PG8_LAS unsigned*)(lds + (bufoff) + ldsw + _i * 8192), 16, 0, 0); } while (0)
#define PG8_LDA(dst, b, h) do { _Pragma("unroll") for (int m = 0; m < 4; ++m) _Pragma("unroll") for (int k = 0; k < 2; ++k) dst[m][k] = *(const PG8_LAS bf16x8*)(lds + PG8_SA(b, h) + aoff + m * 2048 + k * 1024); } while (0)
#define PG8_LDB(dst, b, h) do { _Pragma("unroll") for (int n = 0; n < 2; ++n) _Pragma("unroll") for (int k = 0; k < 2; ++k) dst[n][k] = *(const PG8_LAS bf16x8*)(lds + PG8_SB(b, h) + boff + n * 2048 + k * 1024); } while (0)
#define PG8_MMA(ai, bj, At, Bt) do { __builtin_amdgcn_s_setprio(1); _Pragma("unroll") for (int m = 0; m < 4; ++m) _Pragma("unroll") for (int n = 0; n < 2; ++n) _Pragma("unroll") for (int k = 0; k < 2; ++k) \
        acc[ai][bj][m][n] = __builtin_amdgcn_mfma_f32_16x16x32_bf16(Bt[n][k], At[m][k], acc[ai][bj][m][n], 0, 0, 0); __builtin_amdgcn_s_setprio(0); } while (0)
#define PG8_WAIT_V(n) asm volatile("s_waitcnt vmcnt(" #n ")" ::: "memory")
#define PG8_WAIT_L(n) asm volatile("s_waitcnt lgkmcnt(" #n ")" ::: "memory")
#define PG8_BAR __builtin_amdgcn_s_barrier()
#define PG8_SCHED __builtin_amdgcn_sched_barrier(0)
    Unit cur, nxt; int ui = 0;
    if (!S.next(0, cur)) return;
    f32x4 acc[2][2][4][2];
#pragma unroll
    for (int a = 0; a < 2; ++a)
#pragma unroll
        for (int b = 0; b < 2; ++b)
#pragma unroll
            for (int m = 0; m < 4; ++m)
#pragma unroll
                for (int n = 0; n < 2; ++n) acc[a][b][m][n] = (f32x4){0.f, 0.f, 0.f, 0.f};
    bf16x8 At[4][2], B0[2][2], B1[2][2];
    const char* cA = (const char*)g.A + (size_t)cur.pm * tstep; const char* cB = (const char*)g.Bt + (size_t)cur.pn * tstep;
    S.a_ready(cur);
    if constexpr (SP2) {
        PG8_STAGE(PG8_SB(0, 0), cB, voffB); PG8_STAGE(PG8_SB(0, 1), cB + hstep, voffB); PG8_STAGE(PG8_SA(0, 0), cA, voffA); PG8_STAGE(PG8_SA(0, 1), cA + hstep, voffA);
        if (wr == 1) PG8_BAR;
        PG8_WAIT_V(2); PG8_BAR;
        PG8_STAGE(PG8_SB(1, 0), cB + kstep, voffB); PG8_STAGE(PG8_SA(1, 0), cA + kstep, voffA); PG8_STAGE(PG8_SB(1, 1), cB + hstep + kstep, voffB);
        PG8_WAIT_V(6); PG8_BAR;
    } else {
        PG8_STAGE(PG8_SB(0, 0), cB, voffB); PG8_STAGE(PG8_SA(0, 0), cA, voffA); PG8_STAGE(PG8_SB(0, 1), cB + hstep, voffB); PG8_STAGE(PG8_SA(0, 1), cA + hstep, voffA);
        if (wr == 1) PG8_BAR;
        PG8_WAIT_V(4); PG8_BAR;
        PG8_STAGE(PG8_SB(1, 0), cB + kstep, voffB); PG8_STAGE(PG8_SA(1, 0), cA + kstep, voffA); PG8_STAGE(PG8_SB(1, 1), cB + hstep + kstep, voffB);
        PG8_WAIT_V(6); PG8_BAR;
    }
    for (;;) {
        const bool has_next = S.next(ui + 1, nxt);
        const char* nA = has_next ? (const char*)g.A + (size_t)nxt.pm * tstep : cA; const char* nB = has_next ? (const char*)g.Bt + (size_t)nxt.pn * tstep : cB;
        for (int t = 0; t < nt; t += 2) {
            const bool last = (t == nt - 2);
            const char* a1 = cA + (size_t)(t + 1) * kstep;
            const char* a2 = last ? nA : cA + (size_t)(t + 2) * kstep; const char* b2 = last ? nB : cB + (size_t)(t + 2) * kstep;
            const char* a3 = a2 + kstep; const char* b3 = b2 + kstep;
            if (last && has_next) S.a_ready(nxt);
            if constexpr (SP2) {
            PG8_LDB(B0, 0, 0); PG8_LDB(B1, 0, 1); PG8_SCHED; PG8_LDA(At, 0, 0); PG8_STAGE(PG8_SA(1, 1), a1 + hstep, voffA);
            PG8_WAIT_V(8); PG8_WAIT_L(0); PG8_BAR; PG8_MMA(0, 0, At, B0); PG8_MMA(0, 1, At, B1); PG8_BAR; PG8_SCHED;
            PG8_LDA(At, 0, 1); PG8_STAGE(PG8_SB(0, 0), b2, voffB); PG8_STAGE(PG8_SB(0, 1), b2 + hstep, voffB); PG8_STAGE(PG8_SA(0, 0), a2, voffA);
            PG8_WAIT_V(8); PG8_WAIT_L(0); PG8_BAR; PG8_MMA(1, 0, At, B0); PG8_MMA(1, 1, At, B1); PG8_BAR; PG8_SCHED;
            PG8_LDB(B0, 1, 0); PG8_LDB(B1, 1, 1); PG8_SCHED; PG8_LDA(At, 1, 0); PG8_STAGE(PG8_SA(0, 1), a2 + hstep, voffA);
            PG8_WAIT_V(8); PG8_WAIT_L(0); PG8_BAR; PG8_MMA(0, 0, At, B0); PG8_MMA(0, 1, At, B1); PG8_BAR; PG8_SCHED;
            PG8_LDA(At, 1, 1); PG8_STAGE(PG8_SB(1, 0), b3, voffB); PG8_STAGE(PG8_SB(1, 1), b3 + hstep, voffB); PG8_STAGE(PG8_SA(1, 0), a3, voffA);
            PG8_WAIT_V(8); PG8_WAIT_L(0); PG8_BAR; PG8_MMA(1, 0, At, B0); PG8_MMA(1, 1, At, B1); PG8_BAR; PG8_SCHED;
            } else {
            PG8_LDB(B0, 0, 0); PG8_SCHED; PG8_LDA(At, 0, 0); PG8_STAGE(PG8_SA(1, 1), a1 + hstep, voffA);
            PG8_WAIT_L(8); PG8_BAR; PG8_WAIT_L(0); PG8_MMA(0, 0, At, B0); PG8_BAR; PG8_SCHED;
            PG8_LDB(B1, 0, 1); PG8_STAGE(PG8_SB(0, 0), b2, voffB);
            PG8_BAR; PG8_WAIT_L(0); PG8_MMA(0, 1, At, B1); PG8_BAR;
            PG8_LDA(At, 0, 1); PG8_STAGE(PG8_SA(0, 0), a2, voffA);
            PG8_BAR; PG8_WAIT_L(0); PG8_MMA(1, 0, At, B0); PG8_BAR; PG8_SCHED;
            PG8_STAGE(PG8_SB(0, 1), b2 + hstep, voffB);
            PG8_WAIT_V(6); PG8_BAR; PG8_MMA(1, 1, At, B1); PG8_BAR;
            PG8_LDB(B0, 1, 0); PG8_SCHED; PG8_LDA(At, 1, 0); PG8_STAGE(PG8_SA(0, 1), a2 + hstep, voffA);
            PG8_WAIT_L(8); PG8_BAR; PG8_WAIT_L(0); PG8_MMA(0, 0, At, B0); PG8_BAR; PG8_SCHED;
            PG8_LDB(B1, 1, 1); PG8_STAGE(PG8_SB(1, 0), b3, voffB);
            PG8_BAR; PG8_WAIT_L(0); PG8_MMA(0, 1, At, B1); PG8_BAR;
            PG8_LDA(At, 1, 1); PG8_STAGE(PG8_SA(1, 0), a3, voffA);
            PG8_BAR; PG8_WAIT_L(0); PG8_MMA(1, 0, At, B0); PG8_BAR; PG8_SCHED;
            PG8_STAGE(PG8_SB(1, 1), b3 + hstep, voffB);
            PG8_WAIT_V(6); PG8_BAR; PG8_MMA(1, 1, At, B1); PG8_BAR;
            }
        }
        if constexpr (ALIGN_EPI) { if (wr == 0) PG8_BAR; }
        if constexpr (!Epi::AFTER_DRAIN) { E(acc, cur, wr, wc, fr, fq); S.done(cur); }
        if (!has_next) break;
#pragma unroll
        for (int a = 0; a < 2; ++a)
#pragma unroll
            for (int b = 0; b < 2; ++b)
#pragma unroll
                for (int m = 0; m < 4; ++m)
#pragma unroll
                    for (int n = 0; n < 2; ++n) acc[a][b][m][n] = (f32x4){0.f, 0.f, 0.f, 0.f};
        cur = nxt; cA = nA; cB = nB; ++ui;
        if constexpr (ALIGN_EPI) { if (wr == 1) PG8_BAR; }
    }
    PG8_WAIT_V(0);
    if constexpr (!ALIGN_EPI) { if (wr == 0) PG8_BAR; }
    PG8_BAR;
    if constexpr (Epi::AFTER_DRAIN) { E.fused(acc, cur, wr, wc, fr, fq, lds, wid, lane); S.done(cur); }
#undef PG8_SA
#undef PG8_SB
#undef PG8_STAGE
#undef PG8_LDA
#undef PG8_LDB
#undef PG8_MMA
#undef PG8_WAIT_V
#undef PG8_WAIT_L
#undef PG8_BAR
#undef PG8_SCHED
}
}
#define GAS __attribute__((address_space(1)))
#define LAS __attribute__((address_space(3)))
typedef unsigned short bf16;
typedef unsigned v4u __attribute__((ext_vector_type(4)));
typedef float f32x4 __attribute__((ext_vector_type(4)));
typedef short bf16x8 __attribute__((ext_vector_type(8)));
typedef GAS unsigned gu32;
typedef GAS unsigned long long gu64;
#define RLX_AGENT __ATOMIC_RELAXED, __HIP_MEMORY_SCOPE_AGENT
#define LDS_WAIT() asm volatile("s_waitcnt lgkmcnt(0)" ::: "memory")
#define VM_WAIT() asm volatile("s_waitcnt vmcnt(0)" ::: "memory")
__device__ __forceinline__ unsigned long long rt() { return __builtin_amdgcn_s_memrealtime(); }
__device__ __forceinline__ unsigned f2bf(float f) { unsigned u = __builtin_bit_cast(unsigned, f); return (u + 0x7fffu + ((u >> 16) & 1u)) >> 16; }
__device__ __forceinline__ unsigned pk2(float lo, float hi) { return f2bf(lo) | (f2bf(hi) << 16); }
#define XB_TMO      128
#define XB_XCNT(j)  (256  + 64 * (j))
#define XB_XSUB(j)  (1280 + 64 * (j))
#define XB_XGEN(j)  (2304 + 64 * (j))
#define XB_TOP      3328
#define XB_TOPGEN   3392
#define XCD_BAR_WORDS 3456
#define XB_SPIN_CAP (1u << 18)

__device__ __forceinline__ unsigned xb_ld(unsigned* p)              { return __hip_atomic_load(p, __ATOMIC_RELAXED, __HIP_MEMORY_SCOPE_AGENT); }
__device__ __forceinline__ unsigned xb_add(unsigned* p, unsigned v) { return __hip_atomic_fetch_add(p, v, __ATOMIC_RELAXED, __HIP_MEMORY_SCOPE_AGENT); }
__device__ __forceinline__ unsigned xb_xcc_id() { return (unsigned)__builtin_amdgcn_s_getreg((3 << 11) | 20) & 0xFu; }
#define XB_SPIN(cond, bar) do { unsigned _sp = 0; while (cond) { __builtin_amdgcn_s_sleep(1); \
    if ((++_sp & 255u) == 0u) { if (xb_ld(&(bar)[XB_TMO])) break; if (_sp > XB_SPIN_CAP) { atomicAdd(&(bar)[XB_TMO], 1u); break; } } } } while (0)

struct XcdBarrier {
    unsigned* bar; unsigned x;
    volatile LAS unsigned* st;
};

__device__ __forceinline__ XcdBarrier xcd_barrier_post(unsigned* bar, volatile LAS unsigned* st) {
    XcdBarrier b; b.bar = bar; b.x = xb_xcc_id(); b.st = st;
    if (threadIdx.x == 0) (void)xb_add(&bar[XB_XCNT(b.x)], 1u);
    return b;
}
__device__ __forceinline__ void xcd_barrier_complete(unsigned* bar, unsigned x, unsigned& nloc, unsigned& nx) {
    const unsigned G = gridDim.x * gridDim.y * gridDim.z;
    unsigned sum, cnt, mine, sp = 0u;
    for (;;) {
        sum = 0u; cnt = 0u; mine = 0u;
#pragma unroll
        for (unsigned j = 0; j < 16; ++j) { const unsigned c = xb_ld(&bar[XB_XCNT(j)]); sum += c; cnt += (c > 0u) ? 1u : 0u; mine = (j == x) ? c : mine; }
        if (sum == G) break;
        __builtin_amdgcn_s_sleep(1);
        if ((++sp & 255u) == 0u) { if (xb_ld(&bar[XB_TMO])) break; if (sp > XB_SPIN_CAP) { atomicAdd(&bar[XB_TMO], 1u); break; } }
    }
    nloc = mine > 0u ? mine : 1u; nx = cnt > 0u ? cnt : 1u;
}

__device__ __forceinline__ void xcd_barrier(const XcdBarrier& b) {
    asm volatile("s_waitcnt vmcnt(0)" ::: "memory");
    __syncthreads();
    if (threadIdx.x == 0) {
        unsigned* bar = b.bar;
        __builtin_amdgcn_s_waitcnt(0);
        unsigned nloc = b.st[0], nx = b.st[1];
        if (nloc == 0u) { xcd_barrier_complete(bar, b.x, nloc, nx); b.st[0] = nloc; b.st[1] = nx; }
        const unsigned old = xb_add(&bar[XB_XSUB(b.x)], 1u);
        const unsigned gen = old / nloc;
        if (old + 1u == (gen + 1u) * nloc) {
            __builtin_amdgcn_fence(__ATOMIC_RELEASE, "agent");
            asm volatile("s_waitcnt vmcnt(0)" ::: "memory");
            const unsigned og = xb_add(&bar[XB_TOP], 1u);
            const unsigned tg = og / nx;
            if (og + 1u == (tg + 1u) * nx) xb_add(&bar[XB_TOPGEN], 1u);
            else XB_SPIN(xb_ld(&bar[XB_TOPGEN]) == tg, bar);
            __builtin_amdgcn_fence(__ATOMIC_ACQUIRE, "agent");
            xb_add(&bar[XB_XGEN(b.x)], 1u);
            asm volatile("s_waitcnt vmcnt(0)" ::: "memory");
        } else {
            XB_SPIN(xb_ld(&bar[XB_XGEN(b.x)]) == gen, bar);
            __builtin_amdgcn_fence(__ATOMIC_ACQUIRE, "agent");
            asm volatile("s_waitcnt vmcnt(0)" ::: "memory");
        }
    }
    __syncthreads();
}
#define DI __device__ __forceinline__
typedef float f32x16 __attribute__((ext_vector_type(16)));
constexpr int NWAVES = 8, NTHREADS = 512;
constexpr int NB = 8, SEQ = 2048, DM = 1024, M_TOK = NB * SEQ, FF = 4096, DEPTH = 4, INW = 3224;
constexpr int N2 = 1280, N1 = 2048;
constexpr int NHEAD = 6, HD = 64, NCHUNK = SEQ / 64;
constexpr float LOG2E = 1.4426950408889634f;
constexpr float C2 = 0.17677669529663687f * 1.4426950408889634f;
constexpr int U2_GQ = 0, U2_GK = 384, U2_GV = 768, U2_BF = 1152, U2_BB = 1158, U2_AF = 1164, U2_AB = 1170;
constexpr int U1_DQ = 0, U1_DK = 384, U1_DV = 768, U1_GZ = 1152, U1_CA = 1536, U1_CG = 1792;
constexpr int Y_CONV = 0, Y_DIFF = 256, Y_DELTA = 640;
constexpr size_t MiB = 1u << 20;
constexpr size_t WS_CTL = 0, CTL_ZERO_BYTES = 1 * MiB;
constexpr size_t WS_WIN2 = 2 * MiB;
constexpr size_t WS_WIN1 = WS_WIN2 + (size_t)N2 * DM * 2;
constexpr size_t WS_WOUT = WS_WIN1 + (size_t)N1 * DM * 2;
constexpr size_t WS_WFF1 = WS_WOUT + (size_t)DM * DM * 2;
constexpr size_t WS_WFF2 = WS_WFF1 + (size_t)FF * DM * 2;
constexpr size_t WS_YH = 27 * MiB;
constexpr size_t WS_U = 59 * MiB;
constexpr size_t WS_CH = 123 * MiB;
constexpr size_t WS_OFB = 221 * MiB;
constexpr size_t WS_T = 59 * MiB;
constexpr size_t WS_HID = 128 * MiB;
constexpr size_t WS_END = 256 * MiB;
static_assert(WS_WFF2 + (size_t)DM * FF * 2 <= WS_YH && WS_YH + (size_t)M_TOK * DM * 2 <= WS_U && WS_U + (size_t)M_TOK * N1 * 2 <= WS_CH, "ws map 1");
constexpr size_t CH_UNIT = 66560, CH_QN = 0, CH_KNT = 8192, CH_DIR = 16384, CH_DIRSZ = 24576, CH_W = 0, CH_AQK = 8192, CH_UU = 16384, CH_VEC = 65536;
static_assert(WS_CH + (size_t)NB * NCHUNK * NHEAD * CH_UNIT <= WS_OFB && WS_OFB + 2 * (size_t)M_TOK * 384 * 2 <= WS_END && WS_T + (size_t)M_TOK * DM * 4 <= WS_HID && WS_HID + (size_t)M_TOK * FF * 2 <= WS_END, "ws map 2");
constexpr int CW_TMO = 0, CW_CODE = 1, CW_BAR = 4096;
constexpr int RING_BYTES = 131072, LDS_BYTES = 147456, LDSCTL_OFF = LDS_BYTES - 512, MISC_OFF = LDSCTL_OFF + 320;
static_assert(33600 * 4 <= LDSCTL_OFF && MISC_OFF + 128 <= LDS_BYTES, "LDS map");
DI float bf2f(unsigned b) { return __uint_as_float(b << 16); }
DI float wave_sum(float v) {
#pragma unroll
    for (int o = 1; o < 64; o <<= 1) v += __shfl_xor(v, o);
    return v;
}
DI float wave_max(float v) {
#pragma unroll
    for (int o = 1; o < 64; o <<= 1) v = fmaxf(v, __shfl_xor(v, o));
    return v;
}
DI float sigmoidf_(float x) { return 1.f / (1.f + __expf(-x)); }
DI float siluf_(float x) { return x / (1.f + __expf(-x)); }
DI float softplusf_(float x) { return fmaxf(x, 0.f) + log1pf(__expf(-fabsf(x))); }
DI void unpack8(const v4u r, float (&f)[8]) {
    f[0] = bf2f(r.x & 0xffffu); f[1] = bf2f(r.x >> 16); f[2] = bf2f(r.y & 0xffffu); f[3] = bf2f(r.y >> 16);
    f[4] = bf2f(r.z & 0xffffu); f[5] = bf2f(r.z >> 16); f[6] = bf2f(r.w & 0xffffu); f[7] = bf2f(r.w >> 16);
}
DI v4u pack8(const float (&f)[8]) { v4u o; o.x = pk2(f[0], f[1]); o.y = pk2(f[2], f[3]); o.z = pk2(f[4], f[5]); o.w = pk2(f[6], f[7]); return o; }

struct Args { const float* in[22]; float* out; unsigned char* ws; int ph_lo, ph_hi; };
struct Ctx {
    LAS unsigned char* lds;
    int tid, lane, wave, G, gw, NGW;
    const Args* a;
    DI const float* in(int i) const { return a->in[i]; }
    DI float* out() const { return a->out; }
    DI unsigned char* ws() const { return a->ws; }
    DI bf16* Win2() const { return (bf16*)(a->ws + WS_WIN2); }
    DI bf16* Win1() const { return (bf16*)(a->ws + WS_WIN1); }
    DI bf16* Wout() const { return (bf16*)(a->ws + WS_WOUT); }
    DI bf16* Wff1() const { return (bf16*)(a->ws + WS_WFF1); }
    DI bf16* Wff2() const { return (bf16*)(a->ws + WS_WFF2); }
    DI bf16* YH() const { return (bf16*)(a->ws + WS_YH); }
    DI bf16* U() const { return (bf16*)(a->ws + WS_U); }
    DI bf16* OF() const { return (bf16*)(a->ws + WS_OFB); }
    DI bf16* OB() const { return (bf16*)(a->ws + WS_OFB) + (size_t)M_TOK * 384; }
    DI bf16* HID() const { return (bf16*)(a->ws + WS_HID); }
    DI float* T() const { return (float*)(a->ws + WS_T); }
    DI unsigned char* CH() const { return a->ws + WS_CH; }
};

DI int src_col(int which, int n, float& sc) {
    sc = 1.f;
    if (which == 0) { if (n < 1152) return n + 1664; if (n < 1176) return n + 2048; return -1; }
    if (which == 1) { if (n < 384) sc = C2; if (n < 1152) return n + 512; if (n < 1536) return n + 1664; return n - 1536; }
    return n;
}
DI void convert_item(const float* W, int K, int Nsrc, bf16* WT, int which, int nblk, int item, LAS float* scr, int lane) {
    const int kb = item / nblk, nb = item % nblk, k0 = 64 * kb, n0 = 32 * nb;
    float sc; const int src = src_col(which, n0 + (lane & 31), sc);
#pragma unroll 8
    for (int i = 0; i < 32; ++i) { const int kk = 2 * i + (lane >> 5); scr[kk * 33 + (lane & 31)] = (src >= 0) ? W[(size_t)(k0 + kk) * Nsrc + src] * sc : 0.f; }
    LDS_WAIT(); asm volatile("" ::: "memory");
    const int c = lane & 7;
#pragma unroll
    for (int j = 0; j < 4; ++j) { const int n = (lane >> 3) + 8 * j; const LAS float* s = scr + (8 * c) * 33 + n;
        v4u o; o.x = pk2(s[0 * 33], s[1 * 33]); o.y = pk2(s[2 * 33], s[3 * 33]); o.z = pk2(s[4 * 33], s[5 * 33]); o.w = pk2(s[6 * 33], s[7 * 33]);
        *(GAS v4u*)(WT + (size_t)(n0 + n) * K + k0 + 8 * c) = o; }
    LDS_WAIT(); asm volatile("" ::: "memory");
}
DI void convert_layer(const Ctx& C, int l) {
    LAS float* scr = (LAS float*)(C.lds + C.wave * 16384);
    constexpr int I2 = (DM / 64) * (N2 / 32), I1 = (DM / 64) * (N1 / 32), IO = (DM / 64) * (DM / 32), IF1 = (DM / 64) * (FF / 32), IF2 = (FF / 64) * (DM / 32);
    const float* win = C.in(1) + (size_t)l * DM * INW; const float* wout = C.in(2) + (size_t)l * DM * DM;
    const float* wf1 = C.in(7) + (size_t)l * DM * FF; const float* wf2 = C.in(8) + (size_t)l * FF * DM;
    for (int it = C.gw; it < I2 + I1 + IO + IF1 + IF2; it += C.NGW) {
        int r = it;
        if (r < I2) { convert_item(win, DM, INW, C.Win2(), 0, N2 / 32, r, scr, C.lane); continue; } r -= I2;
        if (r < I1) { convert_item(win, DM, INW, C.Win1(), 1, N1 / 32, r, scr, C.lane); continue; } r -= I1;
        if (r < IO) { convert_item(wout, DM, DM, C.Wout(), 2, DM / 32, r, scr, C.lane); continue; } r -= IO;
        if (r < IF1) { convert_item(wf1, DM, FF, C.Wff1(), 2, FF / 32, r, scr, C.lane); continue; } r -= IF1;
        convert_item(wf2, FF, DM, C.Wff2(), 2, DM / 32, r, scr, C.lane);
    }
}
DI void rowwise(const Ctx& C, const float* t, const float* xin, float* xout, const float* wpost, const float* wpre, bf16* hn) {
    for (int row = C.gw; row < M_TOK; row += C.NGW) {
        const GAS f32x4* xr = (const GAS f32x4*)(xin + (size_t)row * DM) + C.lane;
        f32x4 v[4];
#pragma unroll
        for (int j = 0; j < 4; ++j) v[j] = xr[64 * j];
        if (t) {
            const GAS f32x4* tr = (const GAS f32x4*)(t + (size_t)row * DM) + C.lane; f32x4 tv[4]; float s = 0.f;
#pragma unroll
            for (int j = 0; j < 4; ++j) { tv[j] = tr[64 * j]; s += (tv[j].x * tv[j].x + tv[j].y * tv[j].y) + (tv[j].z * tv[j].z + tv[j].w * tv[j].w); }
            const float r = rsqrtf(wave_sum(s) * (1.f / DM) + 1e-6f);
#pragma unroll
            for (int j = 0; j < 4; ++j) { const f32x4 w = *((const GAS f32x4*)wpost + C.lane + 64 * j); v[j] = v[j] + tv[j] * r * w; }
        }
        if (t || xout != xin) { GAS f32x4* xo = (GAS f32x4*)(xout + (size_t)row * DM) + C.lane;
#pragma unroll
            for (int j = 0; j < 4; ++j) xo[64 * j] = v[j]; }
        if (wpre) {
            float s = 0.f;
#pragma unroll
            for (int j = 0; j < 4; ++j) s += (v[j].x * v[j].x + v[j].y * v[j].y) + (v[j].z * v[j].z + v[j].w * v[j].w);
            const float r = rsqrtf(wave_sum(s) * (1.f / DM) + 1e-6f);
            GAS unsigned long long* o8 = (GAS unsigned long long*)(hn + (size_t)row * DM) + C.lane;
#pragma unroll
            for (int j = 0; j < 4; ++j) { const f32x4 w = *((const GAS f32x4*)wpre + C.lane + 64 * j); const f32x4 o = v[j] * r * w;
                o8[64 * j] = (unsigned long long)pk2(o.x, o.y) | ((unsigned long long)pk2(o.z, o.w) << 32); }
        }
    }
}
template <int MODE  > DI void gemm_simple(const Ctx& C, const bf16* A, const bf16* Bt, int N, int K, void* out, int ldc) {
    const int r = C.lane & 31, h = C.lane >> 5, tn = N / 64, tiles = (M_TOK / 64) * tn;
    for (int t = C.gw; t < tiles; t += C.NGW) {
        const int m0 = (t / tn) * 64, n0 = (t % tn) * 64;
        f32x16 acc[2][2];
#pragma unroll
        for (int i = 0; i < 2; ++i)
#pragma unroll
            for (int j = 0; j < 2; ++j)
#pragma unroll
                for (int e = 0; e < 16; ++e) acc[i][j][e] = 0.f;
        const bf16* ap = A + (size_t)(m0 + r) * K + 8 * h; const bf16* bp = Bt + (size_t)(n0 + r) * K + 8 * h;
        for (int k0 = 0; k0 < K; k0 += 16) {
            bf16x8 a[2], b[2];
#pragma unroll
            for (int i = 0; i < 2; ++i) { a[i] = *(const bf16x8*)(ap + (size_t)(32 * i) * K + k0); b[i] = *(const bf16x8*)(bp + (size_t)(32 * i) * K + k0); }
#pragma unroll
            for (int i = 0; i < 2; ++i)
#pragma unroll
                for (int j = 0; j < 2; ++j) acc[i][j] = __builtin_amdgcn_mfma_f32_32x32x16_bf16(a[i], b[j], acc[i][j], 0, 0, 0);
        }
#pragma unroll
        for (int i = 0; i < 2; ++i)
#pragma unroll
            for (int j = 0; j < 2; ++j)
#pragma unroll
                for (int e = 0; e < 16; ++e) {
                    const int row = m0 + 32 * i + (e & 3) + 8 * (e >> 2) + 4 * h, col = n0 + 32 * j + r; float v = acc[i][j][e];
                    if (MODE == 2) ((float*)out)[(size_t)row * ldc + col] = v;
                    else { if (MODE == 1) { v = fmaxf(v, 0.f); v = v * v; } ((bf16*)out)[(size_t)row * ldc + col] = (bf16)f2bf(v); }
                }
    }
}
DI void conv_phase(const Ctx& C, int l) {
    LAS float* glu = (LAS float*)C.lds;
    LAS float* st = (LAS float*)(C.lds + 94 * 256 * 4);
    const float* dww = C.in(9) + (size_t)l * 31 * 256; const float* dwb = C.in(10) + l * 256; const float* lnw = C.in(11) + l * 256; const float* lnb = C.in(12) + l * 256;
    for (int unit = blockIdx.x; unit < M_TOK / 64; unit += C.G) {
        const int b = unit / NCHUNK, n = unit % NCHUNK, p0 = n * 64 - 15;
        for (int idx = C.tid; idx < 94 * 32; idx += NTHREADS) {
            const int rr = idx >> 5, c8 = (idx & 31) * 8, p = p0 + rr;
            float o[8];
            if (p >= 0 && p < SEQ) {
                const bf16* row = C.U() + (size_t)(b * SEQ + p) * N1;
                const v4u av = *(const GAS v4u*)(row + U1_CA + c8), gv = *(const GAS v4u*)(row + U1_CG + c8);
                float a[8], g[8]; unpack8(av, a); unpack8(gv, g);
#pragma unroll
                for (int e = 0; e < 8; ++e) o[e] = a[e] * sigmoidf_(g[e]);
            } else {
#pragma unroll
                for (int e = 0; e < 8; ++e) o[e] = 0.f;
            }
            *(LAS f32x4*)(glu + rr * 256 + c8) = (f32x4){o[0], o[1], o[2], o[3]}; *(LAS f32x4*)(glu + rr * 256 + c8 + 4) = (f32x4){o[4], o[5], o[6], o[7]};
        }
        __syncthreads();
        const int c = C.tid & 255, half = C.tid >> 8, wq = C.wave & 3;
        float w[31];
#pragma unroll
        for (int j = 0; j < 31; ++j) w[j] = dww[j * 256 + c];
        const float bias = dwb[c];
        for (int i = 0; i < 32; ++i) {
            const int tt = half * 32 + i; float hv = bias;
#pragma unroll
            for (int j = 0; j < 31; ++j) hv += w[j] * glu[(tt + j) * 256 + c];
            const float s = wave_sum(hv), q = wave_sum(hv * hv);
            if (C.lane == 0) { st[(tt * 4 + wq) * 2] = s; st[(tt * 4 + wq) * 2 + 1] = q; }
        }
        __syncthreads();
        const float gw_ = lnw[c], gb_ = lnb[c];
        for (int i = 0; i < 32; ++i) {
            const int tt = half * 32 + i; float hv = bias;
#pragma unroll
            for (int j = 0; j < 31; ++j) hv += w[j] * glu[(tt + j) * 256 + c];
            const float s = (st[(tt * 4) * 2] + st[(tt * 4 + 1) * 2]) + (st[(tt * 4 + 2) * 2] + st[(tt * 4 + 3) * 2]);
            const float q = (st[(tt * 4) * 2 + 1] + st[(tt * 4 + 1) * 2 + 1]) + (st[(tt * 4 + 2) * 2 + 1] + st[(tt * 4 + 3) * 2 + 1]);
            const float mean = s * (1.f / 256.f), var = fmaxf(q * (1.f / 256.f) - mean * mean, 0.f), r = rsqrtf(var + 1e-5f);
            const float v = (hv - mean) * r * gw_ + gb_;
            C.YH()[(size_t)(b * SEQ + n * 64 + tt) * DM + Y_CONV + c] = (bf16)f2bf(siluf_(v));
        }
        __syncthreads();
    }
}
DI void delta_prep(const Ctx& C, int l) {
    LAS float* L = (LAS float*)C.lds;
    LAS float *qf = L, *kf = L + 4160, *vf = L + 8320, *ar = L + 12480, *qkr = L + 16640, *ad = L + 20800, *xx = L + 24960, *gt = L + 33216;
    const float* dcw = C.in(18) + (size_t)l * 3 * 1152; const float* alog = C.in(19) + l * 12; const float* dtb = C.in(20) + l * 12;
    for (int unit = blockIdx.x; unit < NB * NCHUNK * NHEAD; unit += C.G) {
        const int h = unit % NHEAD, bn = unit / NHEAD, n = bn % NCHUNK, b = bn / NCHUNK;
        const size_t t0 = (size_t)b * SEQ + n * 64;
        unsigned char* chb = C.CH() + (size_t)unit * CH_UNIT;
        {   const int c = C.tid >> 3, d8 = (C.tid & 7) * 8;
#pragma unroll
            for (int part = 0; part < 3; ++part) {
                const int col = U2_GQ + part * 384 + h * 64 + d8, wch = part * 384 + h * 64 + d8;
                float acc[8];
#pragma unroll
                for (int e = 0; e < 8; ++e) acc[e] = 0.f;
#pragma unroll
                for (int j = 0; j < 3; ++j) { const int p = n * 64 + c + j - 1;
                    if (p >= 0 && p < SEQ) { const v4u r = *(const GAS v4u*)(C.U() + (size_t)(b * SEQ + p) * N2 + col); float f[8]; unpack8(r, f);
#pragma unroll
                        for (int e = 0; e < 8; ++e) acc[e] += dcw[j * 1152 + wch + e] * f[e]; } }
#pragma unroll
                for (int e = 0; e < 8; ++e) acc[e] = siluf_(acc[e]);
                if (part < 2) { float ss = 0.f;
#pragma unroll
                    for (int e = 0; e < 8; ++e) ss += acc[e] * acc[e];
                    ss += __shfl_xor(ss, 1); ss += __shfl_xor(ss, 2); ss += __shfl_xor(ss, 4);
                    const float sc = rsqrtf(ss + 1e-6f) * (part == 0 ? 0.125f : 1.f);
#pragma unroll
                    for (int e = 0; e < 8; ++e) acc[e] *= sc; }
                LAS float* dst = (part == 0 ? qf : part == 1 ? kf : vf) + c * 65 + d8;
#pragma unroll
                for (int e = 0; e < 8; ++e) dst[e] = acc[e];
            }
        }
        if (C.tid < 64) { const int c = C.tid; const bf16* row = C.U() + (t0 + c) * N2;
            gt[128 + c] = sigmoidf_(bf2f(row[U2_BF + h])); gt[192 + c] = sigmoidf_(bf2f(row[U2_BB + h]));
            gt[c] = -__expf(alog[h]) * softplusf_(bf2f(row[U2_AF + h]) + dtb[h]); gt[64 + c] = -__expf(alog[6 + h]) * softplusf_(bf2f(row[U2_AB + h]) + dtb[6 + h]); }
        __syncthreads();
        if (C.tid == 0) { float s = 0.f; for (int c = 0; c < 64; ++c) { s += gt[c]; gt[256 + c] = s; } }
        if (C.tid == 64) { float s = 0.f; for (int c = 63; c >= 0; --c) { s += gt[64 + c]; gt[320 + c] = s; } }
        for (int i = 0; i < 8; ++i) { const int idx = C.tid + 512 * i, c = idx >> 6, s = idx & 63; float a = 0.f, q = 0.f;
            for (int d = 0; d < 64; ++d) { const float kd = kf[s * 65 + d]; a += kf[c * 65 + d] * kd; q += qf[c * 65 + d] * kd; }
            ar[c * 65 + s] = a; qkr[c * 65 + s] = q; }
        {   const int c = C.tid >> 3, d8 = (C.tid & 7) * 8; float f[8];
#pragma unroll
            for (int e = 0; e < 8; ++e) f[e] = qf[c * 65 + d8 + e];
            *(GAS v4u*)(chb + CH_QN + (size_t)(c * 64 + d8) * 2) = pack8(f);
#pragma unroll
            for (int e = 0; e < 8; ++e) f[e] = kf[(d8 + e) * 65 + c];
            *(GAS v4u*)(chb + CH_KNT + (size_t)(c * 64 + d8) * 2) = pack8(f);
        }
        __syncthreads();
        for (int dir = 0; dir < 2; ++dir) {
            LAS float* gc = gt + 256 + 64 * dir; LAS float* be = gt + 128 + 64 * dir;
            for (int i = 0; i < 8; ++i) { const int idx = C.tid + 512 * i, c = idx >> 6, s = idx & 63; const bool strict = dir ? (c < s) : (c > s);
                ad[c * 65 + s] = strict ? be[c] * ar[c * 65 + s] * __expf(gc[c] - gc[s]) : 0.f; }
            for (int i = 0; i < 16; ++i) { const int idx = C.tid + 512 * i, c = idx >> 7, col = idx & 127;
                xx[c * 129 + col] = (col < 64) ? be[c] * vf[c * 65 + col] : be[c] * kf[c * 65 + col - 64] * __expf(gc[c]); }
            __syncthreads();
            if (C.tid < 128) { const int col = C.tid;
                if (dir == 0) { for (int c = 1; c < 64; ++c) { float acc = xx[c * 129 + col]; for (int s = 0; s < c; ++s) acc -= ad[c * 65 + s] * xx[s * 129 + col]; xx[c * 129 + col] = acc; } }
                else { for (int c = 62; c >= 0; --c) { float acc = xx[c * 129 + col]; for (int s = c + 1; s < 64; ++s) acc -= ad[c * 65 + s] * xx[s * 129 + col]; xx[c * 129 + col] = acc; } } }
            __syncthreads();
            unsigned char* db = chb + CH_DIR + (size_t)dir * CH_DIRSZ;
            {   const int c = C.tid >> 3, d8 = (C.tid & 7) * 8; float f[8];
#pragma unroll
                for (int e = 0; e < 8; ++e) f[e] = xx[c * 129 + d8 + e];
                *(GAS v4u*)(db + CH_UU + (size_t)(c * 64 + d8) * 2) = pack8(f);
#pragma unroll
                for (int e = 0; e < 8; ++e) f[e] = xx[c * 129 + 64 + d8 + e];
                *(GAS v4u*)(db + CH_W + (size_t)(c * 64 + d8) * 2) = pack8(f);
#pragma unroll
                for (int e = 0; e < 8; ++e) { const int s = d8 + e; const bool incl = dir ? (c <= s) : (c >= s); f[e] = incl ? qkr[c * 65 + s] * __expf(gc[c] - gc[s]) : 0.f; }
                *(GAS v4u*)(db + CH_AQK + (size_t)(c * 64 + d8) * 2) = pack8(f);
            }
            if (C.tid < 64) { const float gl = dir ? gc[0] : gc[63]; float* vec = (float*)(chb + CH_VEC + dir * 512); vec[C.tid] = __expf(gc[C.tid]); vec[64 + C.tid] = __expf(gl - gc[C.tid]); }
            __syncthreads();
        }
    }
}
DI void delta_scan(const Ctx& C) {
    LAS float* L = (LAS float*)C.lds;
    LAS float *S = L, *w_ = L + 4160, *aq = L + 8320, *qn = L + 12480, *kt = L + 16640, *uu = L + 20800, *vn = L + 24960, *eg = L + 29120, *ek = L + 29184;
    for (int unit = blockIdx.x; unit < NB * NHEAD * 2; unit += C.G) {
        const int dir = unit & 1, bh = unit >> 1, h = bh % NHEAD, b = bh / NHEAD;
        for (int i = C.tid; i < 4160; i += NTHREADS) S[i] = 0.f;
        __syncthreads();
        bf16* OD = dir ? C.OB() : C.OF();
        for (int step = 0; step < NCHUNK; ++step) {
            const int n = dir ? NCHUNK - 1 - step : step;
            const unsigned char* chb = C.CH() + (size_t)((b * NCHUNK + n) * NHEAD + h) * CH_UNIT; const unsigned char* db = chb + CH_DIR + (size_t)dir * CH_DIRSZ;
            {   const int c = C.tid >> 3, d8 = (C.tid & 7) * 8; const size_t off = (size_t)(c * 64 + d8) * 2; float f[8];
                unpack8(*(const GAS v4u*)(chb + CH_QN + off), f);
#pragma unroll
                for (int e = 0; e < 8; ++e) qn[c * 65 + d8 + e] = f[e];
                unpack8(*(const GAS v4u*)(chb + CH_KNT + off), f);
#pragma unroll
                for (int e = 0; e < 8; ++e) kt[c * 65 + d8 + e] = f[e];
                unpack8(*(const GAS v4u*)(db + CH_W + off), f);
#pragma unroll
                for (int e = 0; e < 8; ++e) w_[c * 65 + d8 + e] = f[e];
                unpack8(*(const GAS v4u*)(db + CH_AQK + off), f);
#pragma unroll
                for (int e = 0; e < 8; ++e) aq[c * 65 + d8 + e] = f[e];
                unpack8(*(const GAS v4u*)(db + CH_UU + off), f);
#pragma unroll
                for (int e = 0; e < 8; ++e) uu[c * 65 + d8 + e] = f[e];
            }
            if (C.tid < 64) { const float* vec = (const float*)(chb + CH_VEC + dir * 512); eg[C.tid] = vec[C.tid]; ek[C.tid] = vec[64 + C.tid]; }
            __syncthreads();
            const int dv = C.tid & 63, cg_ = C.tid >> 6;
#pragma unroll
            for (int i = 0; i < 8; ++i) { const int c = cg_ * 8 + i; float acc = uu[c * 65 + dv];
                for (int k = 0; k < 64; ++k) acc -= w_[c * 65 + k] * S[k * 65 + dv];
                vn[c * 65 + dv] = acc; }
            __syncthreads();
            const float egl = dir ? eg[0] : eg[63];
            float sn[8];
#pragma unroll
            for (int i = 0; i < 8; ++i) { const int c = cg_ * 8 + i; float a1 = 0.f, a2 = 0.f;
                for (int k = 0; k < 64; ++k) { a1 += qn[c * 65 + k] * S[k * 65 + dv]; a2 += aq[c * 65 + k] * vn[k * 65 + dv]; }
                OD[(size_t)(b * SEQ + n * 64 + c) * 384 + h * 64 + dv] = (bf16)f2bf(eg[c] * a1 + a2); }
#pragma unroll
            for (int i = 0; i < 8; ++i) { const int dk = cg_ * 8 + i; float acc = egl * S[dk * 65 + dv];
                for (int c = 0; c < 64; ++c) acc += kt[dk * 65 + c] * ek[c] * vn[c * 65 + dv];
                sn[i] = acc; }
            __syncthreads();
#pragma unroll
            for (int i = 0; i < 8; ++i) S[(cg_ * 8 + i) * 65 + dv] = sn[i];
            __syncthreads();
        }
    }
}
DI void delta_finish(const Ctx& C, int l) {
    const float w = C.in(21)[l * 64 + C.lane];
    for (int row = C.gw; row < M_TOK; row += C.NGW) {
#pragma unroll
        for (int h = 0; h < NHEAD; ++h) {
            const float o = bf2f(C.OF()[(size_t)row * 384 + h * 64 + C.lane]) + bf2f(C.OB()[(size_t)row * 384 + h * 64 + C.lane]);
            const float r = rsqrtf(wave_sum(o * o) * (1.f / 64.f) + 1e-6f);
            const float z = bf2f(C.U()[(size_t)row * N1 + U1_GZ + h * 64 + C.lane]);
            C.YH()[(size_t)row * DM + Y_DELTA + h * 64 + C.lane] = (bf16)f2bf(o * r * w * siluf_(z));
        }
    }
}
DI float alibi_slope(int h) { return h == 0 ? 0.25f : h == 1 ? 0.0625f : h == 2 ? 0.015625f : h == 3 ? 0.00390625f : h == 4 ? 0.5f : 0.125f; }
DI float diff_lambda(const Ctx& C, int l, float& linit) {
    const float a = (C.lane < 32) ? C.in(13)[l * 32 + (C.lane & 31)] * C.in(14)[l * 32 + (C.lane & 31)] : 0.f;
    const float b = (C.lane < 32) ? C.in(15)[l * 32 + (C.lane & 31)] * C.in(16)[l * 32 + (C.lane & 31)] : 0.f;
    linit = 0.8f - 0.6f * expf(-0.3f * (float)l);
    return expf(wave_sum(a)) - expf(wave_sum(b)) + linit;
}
DI void attn_simple(const Ctx& C, int l) {
    LAS float* sc = (LAS float*)C.lds + C.wave * 2048;
    float linit; const float lam = diff_lambda(C, l, linit);
    const float sw = C.in(17)[l * 64 + C.lane] * (1.f - linit);
    for (int unit = blockIdx.x; unit < NB * NHEAD * (SEQ / 8); unit += C.G) {
        const int bh = unit / (SEQ / 8), qi = (unit % (SEQ / 8)) * 8 + C.wave, b = bh / NHEAD, h = bh % NHEAD;
        const float slope2 = alibi_slope(h) * LOG2E;
        const size_t tq = (size_t)b * SEQ + qi;
        float o[2];
#pragma unroll
        for (int m = 0; m < 2; ++m) {
            const bf16* qp = C.U() + tq * N1 + U1_DQ + h * 64 + m * 32;
            float qv[32];
#pragma unroll
            for (int j = 0; j < 4; ++j) { float f[8]; unpack8(*(const GAS v4u*)(qp + 8 * j), f);
#pragma unroll
                for (int e = 0; e < 8; ++e) qv[8 * j + e] = f[e]; }
            float mx = -INFINITY;
            for (int kb = 0; kb < SEQ / 64; ++kb) {
                const int key = kb * 64 + C.lane; const bf16* kp = C.U() + (size_t)(b * SEQ + key) * N1 + U1_DK + h * 64 + m * 32; float dot = 0.f;
#pragma unroll
                for (int j = 0; j < 4; ++j) { float f[8]; unpack8(*(const GAS v4u*)(kp + 8 * j), f);
#pragma unroll
                    for (int e = 0; e < 8; ++e) dot += qv[8 * j + e] * f[e]; }
                const float s = dot - slope2 * fabsf((float)(qi - key)); sc[key] = s; mx = fmaxf(mx, s);
            }
            mx = wave_max(mx);
            float sum = 0.f;
            for (int kb = 0; kb < SEQ / 64; ++kb) { const int key = kb * 64 + C.lane; const float p = exp2f(sc[key] - mx); sc[key] = p; sum += p; }
            sum = wave_sum(sum);
            LDS_WAIT(); asm volatile("" ::: "memory");
            const bf16* vp = C.U() + (size_t)b * SEQ * N1 + U1_DV + h * 64 + C.lane; float acc = 0.f;
#pragma unroll 8
            for (int key = 0; key < SEQ; ++key) acc += sc[key] * bf2f(vp[(size_t)key * N1]);
            o[m] = acc / sum;
            LDS_WAIT(); asm volatile("" ::: "memory");
        }
        const float a = o[0] - lam * o[1];
        const float r = rsqrtf(wave_sum(a * a) * (1.f / 64.f) + 1e-5f);
        C.YH()[tq * DM + Y_DIFF + h * 64 + C.lane] = (bf16)f2bf(a * r * sw);
    }
}
constexpr int PH_PER_LAYER = 11, NPH = 1 + PH_PER_LAYER * DEPTH;
__global__ void __launch_bounds__(NTHREADS, 2) mega(Args args) {
    extern __shared__ __attribute__((aligned(16))) unsigned char lds_raw[];
    Ctx C;
    C.lds = (LAS unsigned char*)lds_raw;
    C.tid = threadIdx.x; C.lane = C.tid & 63; C.wave = __builtin_amdgcn_readfirstlane(C.tid >> 6);
    C.G = gridDim.x; C.gw = blockIdx.x * NWAVES + C.wave; C.NGW = C.G * NWAVES;
    C.a = &args;
    for (int u = C.tid; u < (LDS_BYTES - LDSCTL_OFF) / 4; u += NTHREADS) ((LAS unsigned*)(C.lds + LDSCTL_OFF))[u] = 0u;
    __syncthreads();
#if MK_SINGLE
    volatile LAS unsigned* MISC = (volatile LAS unsigned*)(C.lds + MISC_OFF);
    XcdBarrier bar = xcd_barrier_post((unsigned*)((gu32*)(C.ws() + WS_CTL) + CW_BAR), MISC + 8);
    cg::grid_group grid = cg::this_grid();
#endif
    for (int p = args.ph_lo; p < args.ph_hi; ++p) {
        { int t_ = threadIdx.x; asm volatile("" : "+v"(t_)); C.tid = t_; C.lane = t_ & 63; }
        if (p == 0) {
#ifndef DIS_ROW
            rowwise(C, nullptr, C.in(0), C.out(), nullptr, C.in(3), C.YH());
#endif
#ifndef DIS_CVT
            convert_layer(C, 0);
#endif
        } else {
            const int l = (p - 1) / PH_PER_LAYER, k = (p - 1) % PH_PER_LAYER;
            if (k == 0) {
#if USE_PG8 == 2
#elif USE_PG8
                pg8::Gemm g{C.YH(), C.Win2(), M_TOK, N2, DM}; pg8::StaticOrder S; S.init(M_TOK, N2, C.G, (int)blockIdx.x);
                pg8::EpiBf16<0> E{C.U(), N2};
                pg8::gemm_phase<pg8::EpiBf16<0>, pg8::StaticOrder, true, true>(C.lds, g, S, E);
#else
                gemm_simple<0>(C, C.YH(), C.Win2(), N2, DM, C.U(), N2);
#endif
            } else if (k == 2) {
#if USE_PG8 == 2
#elif USE_PG8
                pg8::Gemm g{C.YH(), C.Win1(), M_TOK, N1, DM}; pg8::StaticOrder S; S.init(M_TOK, N1, C.G, (int)blockIdx.x);
                pg8::EpiBf16<0> E{C.U(), N1};
                pg8::gemm_phase<pg8::EpiBf16<0>, pg8::StaticOrder, true, true>(C.lds, g, S, E);
#else
                gemm_simple<0>(C, C.YH(), C.Win1(), N1, DM, C.U(), N1);
#endif
            } else if (k == 1) {
#ifndef DIS_PREP
                delta_prep(C, l);
#endif
            } else if (k == 3) {
#ifndef DIS_CONV
                conv_phase(C, l);
#endif
#ifndef DIS_ATTN
                attn_simple(C, l);
#endif
            } else if (k == 4) {
#ifndef DIS_SCAN
                delta_scan(C);
#endif
            } else if (k == 5) {
#ifndef DIS_FIN
                delta_finish(C, l);
#endif
            } else if (k == 6) {
#if USE_PG8 == 2
#elif USE_PG8
                pg8::Gemm g{C.YH(), C.Wout(), M_TOK, DM, DM}; pg8::StaticOrder S; S.init(M_TOK, DM, C.G, (int)blockIdx.x);
                pg8::EpiF32 E{C.T(), DM};
                pg8::gemm_phase<pg8::EpiF32, pg8::StaticOrder, true, true>(C.lds, g, S, E);
#else
                gemm_simple<2>(C, C.YH(), C.Wout(), DM, DM, C.T(), DM);
#endif
            } else if (k == 9) {
#if USE_PG8 == 2
#elif USE_PG8
                pg8::Gemm g{C.HID(), C.Wff2(), M_TOK, DM, FF}; pg8::StaticOrder S; S.init(M_TOK, DM, C.G, (int)blockIdx.x);
                pg8::EpiF32 E{C.T(), DM};
                pg8::gemm_phase<pg8::EpiF32, pg8::StaticOrder, true, true>(C.lds, g, S, E);
#else
                gemm_simple<2>(C, C.HID(), C.Wff2(), DM, FF, C.T(), DM);
#endif
            } else if (k == 7) {
#ifndef DIS_ROW
                rowwise(C, C.T(), C.out(), C.out(), C.in(4) + l * DM, C.in(5) + l * DM, C.YH());
#endif
            } else if (k == 8) {
#if USE_PG8 == 2
#elif USE_PG8
                pg8::Gemm g{C.YH(), C.Wff1(), M_TOK, FF, DM}; pg8::StaticOrder S; S.init(M_TOK, FF, C.G, (int)blockIdx.x);
                pg8::EpiBf16<1> E{C.HID(), FF};
                pg8::gemm_phase<pg8::EpiBf16<1>, pg8::StaticOrder, true, true>(C.lds, g, S, E);
#else
                gemm_simple<1>(C, C.YH(), C.Wff1(), FF, DM, C.HID(), FF);
#endif
            } else {
#ifndef DIS_ROW
                rowwise(C, C.T(), C.out(), C.out(), C.in(6) + l * DM, (l + 1 < DEPTH) ? C.in(3) + (l + 1) * DM : nullptr, C.YH());
#endif
#ifndef DIS_CVT
                if (l + 1 < DEPTH) convert_layer(C, l + 1);
#endif
            }
        }
#if MK_SINGLE
        if (p + 1 < args.ph_hi) { if (p == 0) grid.sync(); else xcd_barrier(bar); }
#else
        __syncthreads();
#endif
    }
}

extern "C" void kernel_launch(void* const* d_in, const int* in_sizes, int n_in, void* d_out, int out_size, void* d_ws, size_t ws_size, hipStream_t stream) {
    static int grid = 0;
    if (grid == 0) {
        if (n_in != 22 || in_sizes[0] != M_TOK * DM || out_size != M_TOK * DM || ws_size < WS_END) {
            fprintf(stderr, "kernel_launch: unexpected problem: n_in %d in0 %d out %d ws %zu (need >= %zu)\n", n_in, n_in > 0 ? in_sizes[0] : -1, out_size, ws_size, (size_t)WS_END); grid = -1; return; }
        int dev = 0, cus = 0, per_cu = 0;
        if (hipGetDevice(&dev) != hipSuccess || hipDeviceGetAttribute(&cus, hipDeviceAttributeMultiprocessorCount, dev) != hipSuccess) { fprintf(stderr, "kernel_launch: device query failed\n"); grid = -1; return; }
        if (hipFuncSetAttribute((const void*)mega, hipFuncAttributeMaxDynamicSharedMemorySize, LDS_BYTES) != hipSuccess) { fprintf(stderr, "kernel_launch: hipFuncSetAttribute failed\n"); grid = -1; return; }
        if (hipOccupancyMaxActiveBlocksPerMultiprocessor(&per_cu, (const void*)mega, NTHREADS, LDS_BYTES) != hipSuccess || per_cu < 1) { fprintf(stderr, "kernel_launch: occupancy query says %d blocks per CU\n", per_cu); per_cu = 1; }
        (void)hipGetLastError();
        grid = cus;
        if (grid != 256) fprintf(stderr, "kernel_launch: note: %d CUs\n", grid);
    }
    if (grid < 0) return;
    if (hipMemsetAsync((char*)d_ws + WS_CTL, 0, CTL_ZERO_BYTES, stream) != hipSuccess) { fprintf(stderr, "kernel_launch: memset failed\n"); return; }
    Args a{};
    for (int i = 0; i < 22; ++i) a.in[i] = (const float*)d_in[i];
    a.out = (float*)d_out; a.ws = (unsigned char*)d_ws;
#if MK_SINGLE
    a.ph_lo = 0; a.ph_hi = NPH;
    void* kargs[] = {&a};
    const hipError_t e = hipLaunchCooperativeKernel((const void*)mega, dim3(grid), dim3(NTHREADS), kargs, LDS_BYTES, stream);
    if (e != hipSuccess) fprintf(stderr, "kernel_launch: cooperative launch failed: %s (grid %d)\n", hipGetErrorString(e), grid);
#else
    for (int p = 0; p < NPH; ++p) {
        a.ph_lo = p; a.ph_hi = p + 1;
        hipLaunchKernelGGL(mega, dim3(grid), dim3(NTHREADS), LDS_BYTES, stream, a);
        const hipError_t le = hipPeekAtLastError();
        if (le != hipSuccess) { fprintf(stderr, "kernel_launch: launch %d failed: %s\n", p, hipGetErrorName(le)); break; }
    }
#endif
}
```

```cpp
#include <hip/hip_runtime.h>
#include <hip/hip_cooperative_groups.h>
#include <cstdio>
#include <cstdint>
namespace cg = cooperative_groups;
#ifndef MK_SINGLE
#define MK_SINGLE 1
#endif
#ifndef USE_PG8
#define USE_PG8 1
#endif
#ifndef ATTN_SIMPLE
#define ATTN_SIMPLE 0
#endif
#ifndef PREP_SIMPLE
#define PREP_SIMPLE 0
#endif
namespace pg8 {
#define PG8_LAS __attribute__((address_space(3)))
typedef unsigned short bf16_t;
typedef short bf16x8 __attribute__((ext_vector_type(8)));
typedef float f32x4 __attribute__((ext_vector_type(4)));
typedef unsigned u32x4 __attribute__((ext_vector_type(4)));
constexpr int BM = 256, BK = 64, HALF = 128, HTB = HALF * BK * 2  , STAGE_BYTES = 8 * HTB, NXCD = 8, WGM = 8;

__host__ __device__ __forceinline__ int lds_byte(int r, int c) { const int st = (r >> 4) * 2 + (c >> 5), rr = r & 15, cc = c & 31, ob = rr * 64 + cc * 2; return st * 1024 + (ob ^ (((ob >> 9) & 1) << 5)); }
__host__ __device__ __forceinline__ void stage_rc(int b, int& R, int& C) { const int st = b / 1024, sb = b % 1024, swz = sb ^ (((sb >> 9) & 1) << 5); R = (st >> 1) * 16 + swz / 64; C = (st & 1) * 32 + (swz % 64) / 2; }
__host__ __device__ __forceinline__ int perm32(int rho) { const int n = rho >> 4, i = rho & 15; return 8 * (i >> 2) + 4 * n + (i & 3); }

struct Unit { int pm, pn; };
struct Gemm { const bf16_t* A; const bf16_t* Bt; int M, N, K; };

struct StaticOrder {
    int nM, nN, nwg, G, c;
    __host__ __device__ void init(int M, int N, int G_, int c_) { nM = M / BM; nN = N / BM; nwg = nM * nN; G = G_; c = c_; }
    __host__ __device__ bool next(int i, Unit& u) const {
        const long L = (long)i * G + c; if (L >= nwg) return false;
        int wgid = (int)L; { const int q = nwg / NXCD, r = nwg % NXCD, xcd = wgid % NXCD, off = wgid / NXCD; wgid = (xcd < r ? xcd * (q + 1) : r * (q + 1) + (xcd - r) * q) + off; }
        const int nig = WGM * nN, gid = wgid / nig, fm = gid * WGM, gsz = (nM - fm) < WGM ? (nM - fm) : WGM;
        u.pm = fm + ((wgid % nig) % gsz); u.pn = (wgid % nig) / gsz; return true;
    }
    __device__ __forceinline__ void a_ready(const Unit&) const {}
    __device__ __forceinline__ void done(const Unit&) const {}
};

__device__ __forceinline__ unsigned cvt_pk_bf16(float lo, float hi) { unsigned r; asm volatile("v_cvt_pk_bf16_f32 %0, %1, %2" : "=v"(r) : "v"(lo), "v"(hi)); return r; }
typedef float f32x2 __attribute__((ext_vector_type(2)));
template <int ACT> struct EpiBf16 {
    static constexpr bool PERM = true, AFTER_DRAIN = false;
    bf16_t* O; int ldc;
    __device__ __forceinline__ void operator()(const f32x4 (&acc)[2][2][4][2], const Unit& u, int wr, int wc, int fr, int fq) const {
        const int row0 = u.pm * BM + wr * 64 + fr; const int col0 = u.pn * BM + wc * 32 + 8 * fq;
#pragma unroll
        for (int ai = 0; ai < 2; ++ai)
#pragma unroll
            for (int m = 0; m < 4; ++m) { bf16_t* rowp = O + (size_t)(row0 + ai * HALF + m * 16) * ldc + col0;
#pragma unroll
                for (int bj = 0; bj < 2; ++bj) { f32x4 v0 = acc[ai][bj][m][0], v1 = acc[ai][bj][m][1];
                    if (ACT == 1) {
#pragma unroll
                        for (int j = 0; j < 4; ++j) { const float a = fmaxf(v0[j], 0.f), b = fmaxf(v1[j], 0.f); v0[j] = a * a; v1[j] = b * b; } }
                    u32x4 w; w.x = cvt_pk_bf16(v0[0], v0[1]); w.y = cvt_pk_bf16(v0[2], v0[3]); w.z = cvt_pk_bf16(v1[0], v1[1]); w.w = cvt_pk_bf16(v1[2], v1[3]);
                    *(u32x4*)(rowp + bj * HALF) = w; } }
    }
};
struct EpiF32 {
    static constexpr bool PERM = false, AFTER_DRAIN = false;
    float* C; int ldc;
    __device__ __forceinline__ void operator()(const f32x4 (&acc)[2][2][4][2], const Unit& u, int wr, int wc, int fr, int fq) const {
        const int row0 = u.pm * BM + wr * 64 + fr, col0 = u.pn * BM + wc * 32 + 4 * fq;
#pragma unroll
        for (int ai = 0; ai < 2; ++ai)
#pragma unroll
            for (int m = 0; m < 4; ++m) { float* rowp = C + (size_t)(row0 + ai * HALF + m * 16) * ldc + col0;
#pragma unroll
                for (int bj = 0; bj < 2; ++bj)
#pragma unroll
                    for (int n = 0; n < 2; ++n) *(f32x4*)(rowp + bj * HALF + n * 16) = acc[ai][bj][m][n]; }
    }
};
template <class Epi, class Sched, bool ALIGN_EPI = false, bool SP2 = false>
__device__ __forceinline__ void gemm_phase(PG8_LAS unsigned char* lds, const Gemm g, const Sched& S, const Epi& E) {
    int tid_ = threadIdx.x; asm volatile("" : "+v"(tid_));
    const int tid = tid_, wid = __builtin_amdgcn_readfirstlane(tid >> 6), lane = tid & 63, wr = wid >> 2, wc = wid & 3, fr = lane & 15, fq = lane >> 4;
    const int K = g.K, nt = K / BK;
    unsigned voffA[2], voffB[2];
#pragma unroll
    for (int i = 0; i < 2; ++i) { int R, C; stage_rc(tid * 16 + i * 8192, R, C); const int Rb = Epi::PERM ? ((R & ~31) + perm32(R & 31)) : R;
        voffA[i] = (unsigned)(R * K + C) * 2u; voffB[i] = (unsigned)(Rb * K + C) * 2u; }
    const size_t kstep = (size_t)(BK * 2);
    const size_t hstep = (size_t)HALF * K * 2;
    const size_t tstep = 2 * hstep;
    const unsigned ldsw = (unsigned)wid * 1024u;
    const int aoff = lds_byte(wr * 64 + fr, fq * 8), boff = lds_byte(wc * 32 + fr, fq * 8);
#define PG8_SA(b, h) (((b) * 2 + (h)) * HTB)
#define PG8_SB(b, h) ((4 + (b) * 2 + (h)) * HTB)
#define PG8_STAGE(bufoff, gbase, voff) do { _Pragma("unroll") for (int _i = 0; _i < 2; ++_i) \
        __builtin_amdgcn_global_load_lds((const unsigned*)((const char*)(gbase) + (voff)[_i]), (PG8_LAS unsigned*)(lds + (bufoff) + ldsw + _i * 8192), 16, 0, 0); } while (0)
#define PG8_LDA(dst, b, h) do { _Pragma("unroll") for (int m = 0; m < 4; ++m) _Pragma("unroll") for (int k = 0; k < 2; ++k) dst[m][k] = *(const PG8_LAS bf16x8*)(lds + PG8_SA(b, h) + aoff + m * 2048 + k * 1024); } while (0)
#define PG8_LDB(dst, b, h) do { _Pragma("unroll") for (int n = 0; n < 2; ++n) _Pragma("unroll") for (int k = 0; k < 2; ++k) dst[n][k] = *(const PG8_LAS bf16x8*)(lds + PG8_SB(b, h) + boff + n * 2048 + k * 1024); } while (0)
#define PG8_MMA(ai, bj, At, Bt) do { __builtin_amdgcn_s_setprio(1); _Pragma("unroll") for (int m = 0; m < 4; ++m) _Pragma("unroll") for (int n = 0; n < 2; ++n) _Pragma("unroll") for (int k = 0; k < 2; ++k) \
        acc[ai][bj][m][n] = __builtin_amdgcn_mfma_f32_16x16x32_bf16(Bt[n][k], At[m][k], acc[ai][bj][m][n], 0, 0, 0); __builtin_amdgcn_s_setprio(0); } while (0)
#define PG8_WAIT_V(n) asm volatile("s_waitcnt vmcnt(" #n ")" ::: "memory")
#define PG8_WAIT_L(n) asm volatile("s_waitcnt lgkmcnt(" #n ")" ::: "memory")
#define PG8_BAR __builtin_amdgcn_s_barrier()
#define PG8_SCHED __builtin_amdgcn_sched_barrier(0)
    Unit cur, nxt; int ui = 0;
    if (!S.next(0, cur)) return;
    f32x4 acc[2][2][4][2];
#pragma unroll
    for (int a = 0; a < 2; ++a)
#pragma unroll
        for (int b = 0; b < 2; ++b)
#pragma unroll
            for (int m = 0; m < 4; ++m)
#pragma unroll
                for (int n = 0; n < 2; ++n) acc[a][b][m][n] = (f32x4){0.f, 0.f, 0.f, 0.f};
    bf16x8 At[4][2], B0[2][2], B1[2][2];
    const char* cA = (const char*)g.A + (size_t)cur.pm * tstep; const char* cB = (const char*)g.Bt + (size_t)cur.pn * tstep;
    S.a_ready(cur);
    if constexpr (SP2) {
        PG8_STAGE(PG8_SB(0, 0), cB, voffB); PG8_STAGE(PG8_SB(0, 1), cB + hstep, voffB); PG8_STAGE(PG8_SA(0, 0), cA, voffA); PG8_STAGE(PG8_SA(0, 1), cA + hstep, voffA);
        if (wr == 1) PG8_BAR;
        PG8_WAIT_V(2); PG8_BAR;
        PG8_STAGE(PG8_SB(1, 0), cB + kstep, voffB); PG8_STAGE(PG8_SA(1, 0), cA + kstep, voffA); PG8_STAGE(PG8_SB(1, 1), cB + hstep + kstep, voffB);
        PG8_WAIT_V(6); PG8_BAR;
    } else {
        PG8_STAGE(PG8_SB(0, 0), cB, voffB); PG8_STAGE(PG8_SA(0, 0), cA, voffA); PG8_STAGE(PG8_SB(0, 1), cB + hstep, voffB); PG8_STAGE(PG8_SA(0, 1), cA + hstep, voffA);
        if (wr == 1) PG8_BAR;
        PG8_WAIT_V(4); PG8_BAR;
        PG8_STAGE(PG8_SB(1, 0), cB + kstep, voffB); PG8_STAGE(PG8_SA(1, 0), cA + kstep, voffA); PG8_STAGE(PG8_SB(1, 1), cB + hstep + kstep, voffB);
        PG8_WAIT_V(6); PG8_BAR;
    }
    for (;;) {
        const bool has_next = S.next(ui + 1, nxt);
        const char* nA = has_next ? (const char*)g.A + (size_t)nxt.pm * tstep : cA; const char* nB = has_next ? (const char*)g.Bt + (size_t)nxt.pn * tstep : cB;
        for (int t = 0; t < nt; t += 2) {
            const bool last = (t == nt - 2);
            const char* a1 = cA + (size_t)(t + 1) * kstep;
            const char* a2 = last ? nA : cA + (size_t)(t + 2) * kstep; const char* b2 = last ? nB : cB + (size_t)(t + 2) * kstep;
            const char* a3 = a2 + kstep; const char* b3 = b2 + kstep;
            if (last && has_next) S.a_ready(nxt);
            if constexpr (SP2) {
            PG8_LDB(B0, 0, 0); PG8_LDB(B1, 0, 1); PG8_SCHED; PG8_LDA(At, 0, 0); PG8_STAGE(PG8_SA(1, 1), a1 + hstep, voffA);
            PG8_WAIT_V(8); PG8_WAIT_L(0); PG8_BAR; PG8_MMA(0, 0, At, B0); PG8_MMA(0, 1, At, B1); PG8_BAR; PG8_SCHED;
            PG8_LDA(At, 0, 1); PG8_STAGE(PG8_SB(0, 0), b2, voffB); PG8_STAGE(PG8_SB(0, 1), b2 + hstep, voffB); PG8_STAGE(PG8_SA(0, 0), a2, voffA);
            PG8_WAIT_V(8); PG8_WAIT_L(0); PG8_BAR; PG8_MMA(1, 0, At, B0); PG8_MMA(1, 1, At, B1); PG8_BAR; PG8_SCHED;
            PG8_LDB(B0, 1, 0); PG8_LDB(B1, 1, 1); PG8_SCHED; PG8_LDA(At, 1, 0); PG8_STAGE(PG8_SA(0, 1), a2 + hstep, voffA);
            PG8_WAIT_V(8); PG8_WAIT_L(0); PG8_BAR; PG8_MMA(0, 0, At, B0); PG8_MMA(0, 1, At, B1); PG8_BAR; PG8_SCHED;
            PG8_LDA(At, 1, 1); PG8_STAGE(PG8_SB(1, 0), b3, voffB); PG8_STAGE(PG8_SB(1, 1), b3 + hstep, voffB); PG8_STAGE(PG8_SA(1, 0), a3, voffA);
            PG8_WAIT_V(8); PG8_WAIT_L(0); PG8_BAR; PG8_MMA(1, 0, At, B0); PG8_MMA(1, 1, At, B1); PG8_BAR; PG8_SCHED;
            } else {
            PG8_LDB(B0, 0, 0); PG8_SCHED; PG8_LDA(At, 0, 0); PG8_STAGE(PG8_SA(1, 1), a1 + hstep, voffA);
            PG8_WAIT_L(8); PG8_BAR; PG8_WAIT_L(0); PG8_MMA(0, 0, At, B0); PG8_BAR; PG8_SCHED;
            PG8_LDB(B1, 0, 1); PG8_STAGE(PG8_SB(0, 0), b2, voffB);
            PG8_BAR; PG8_WAIT_L(0); PG8_MMA(0, 1, At, B1); PG8_BAR;
            PG8_LDA(At, 0, 1); PG8_STAGE(PG8_SA(0, 0), a2, voffA);
            PG8_BAR; PG8_WAIT_L(0); PG8_MMA(1, 0, At, B0); PG8_BAR; PG8_SCHED;
            PG8_STAGE(PG8_SB(0, 1), b2 + hstep, voffB);
            PG8_WAIT_V(6); PG8_BAR; PG8_MMA(1, 1, At, B1); PG8_BAR;
            PG8_LDB(B0, 1, 0); PG8_SCHED; PG8_LDA(At, 1, 0); PG8_STAGE(PG8_SA(0, 1), a2 + hstep, voffA);
            PG8_WAIT_L(8); PG8_BAR; PG8_WAIT_L(0); PG8_MMA(0, 0, At, B0); PG8_BAR; PG8_SCHED;
            PG8_LDB(B1, 1, 1); PG8_STAGE(PG8_SB(1, 0), b3, voffB);
            PG8_BAR; PG8_WAIT_L(0); PG8_MMA(0, 1, At, B1); PG8_BAR;
            PG8_LDA(At, 1, 1); PG8_STAGE(PG8_SA(1, 0), a3, voffA);
            PG8_BAR; PG8_WAIT_L(0); PG8_MMA(1, 0, At, B0); PG8_BAR; PG8_SCHED;
            PG8_STAGE(PG8_SB(1, 1), b3 + hstep, voffB);
            PG8_WAIT_V(6); PG8_BAR; PG8_MMA(1, 1, At, B1); PG8_BAR;
            }
        }
        if constexpr (ALIGN_EPI) { if (wr == 0) PG8_BAR; }
        if constexpr (!Epi::AFTER_DRAIN) { E(acc, cur, wr, wc, fr, fq); S.done(cur); }
        if (!has_next) break;
#pragma unroll
        for (int a = 0; a < 2; ++a)
#pragma unroll
            for (int b = 0; b < 2; ++b)
#pragma unroll
                for (int m = 0; m < 4; ++m)
#pragma unroll
                    for (int n = 0; n < 2; ++n) acc[a][b][m][n] = (f32x4){0.f, 0.f, 0.f, 0.f};
        cur = nxt; cA = nA; cB = nB; ++ui;
        if constexpr (ALIGN_EPI) { if (wr == 1) PG8_BAR; }
    }
    PG8_WAIT_V(0);
    if constexpr (!ALIGN_EPI) { if (wr == 0) PG8_BAR; }
    PG8_BAR;
    if constexpr (Epi::AFTER_DRAIN) { E.fused(acc, cur, wr, wc, fr, fq, lds, wid, lane); S.done(cur); }
#undef PG8_SA
#undef PG8_SB
#undef PG8_STAGE
#undef PG8_LDA
#undef PG8_LDB
#undef PG8_MMA
#undef PG8_WAIT_V
#undef PG8_WAIT_L
#undef PG8_BAR
#undef PG8_SCHED
}
}
#define GAS __attribute__((address_space(1)))
#define LAS __attribute__((address_space(3)))
typedef unsigned short bf16;
typedef unsigned v4u __attribute__((ext_vector_type(4)));
typedef float f32x4 __attribute__((ext_vector_type(4)));
typedef short bf16x8 __attribute__((ext_vector_type(8)));
typedef GAS unsigned gu32;
typedef GAS unsigned long long gu64;
#define RLX_AGENT __ATOMIC_RELAXED, __HIP_MEMORY_SCOPE_AGENT
#define LDS_WAIT() asm volatile("s_waitcnt lgkmcnt(0)" ::: "memory")
#define VM_WAIT() asm volatile("s_waitcnt vmcnt(0)" ::: "memory")
__device__ __forceinline__ unsigned long long rt() { return __builtin_amdgcn_s_memrealtime(); }
__device__ __forceinline__ unsigned f2bf(float f) { unsigned u = __builtin_bit_cast(unsigned, f); return (u + 0x7fffu + ((u >> 16) & 1u)) >> 16; }
__device__ __forceinline__ unsigned pk2(float lo, float hi) { return f2bf(lo) | (f2bf(hi) << 16); }
#define XB_TMO      128
#define XB_XCNT(j)  (256  + 64 * (j))
#define XB_XSUB(j)  (1280 + 64 * (j))
#define XB_XGEN(j)  (2304 + 64 * (j))
#define XB_TOP      3328
#define XB_TOPGEN   3392
#define XCD_BAR_WORDS 3456
#define XB_SPIN_CAP (1u << 18)

__device__ __forceinline__ unsigned xb_ld(unsigned* p)              { return __hip_atomic_load(p, __ATOMIC_RELAXED, __HIP_MEMORY_SCOPE_AGENT); }
__device__ __forceinline__ unsigned xb_add(unsigned* p, unsigned v) { return __hip_atomic_fetch_add(p, v, __ATOMIC_RELAXED, __HIP_MEMORY_SCOPE_AGENT); }
__device__ __forceinline__ unsigned xb_xcc_id() { return (unsigned)__builtin_amdgcn_s_getreg((3 << 11) | 20) & 0xFu; }
#define XB_SPIN(cond, bar) do { unsigned _sp = 0; while (cond) { __builtin_amdgcn_s_sleep(1); \
    if ((++_sp & 255u) == 0u) { if (xb_ld(&(bar)[XB_TMO])) break; if (_sp > XB_SPIN_CAP) { atomicAdd(&(bar)[XB_TMO], 1u); break; } } } } while (0)

struct XcdBarrier {
    unsigned* bar; unsigned x;
    volatile LAS unsigned* st;
};

__device__ __forceinline__ XcdBarrier xcd_barrier_post(unsigned* bar, volatile LAS unsigned* st) {
    XcdBarrier b; b.bar = bar; b.x = xb_xcc_id(); b.st = st;
    if (threadIdx.x == 0) (void)xb_add(&bar[XB_XCNT(b.x)], 1u);
    return b;
}
__device__ __forceinline__ void xcd_barrier_complete(unsigned* bar, unsigned x, unsigned& nloc, unsigned& nx) {
    const unsigned G = gridDim.x * gridDim.y * gridDim.z;
    unsigned sum, cnt, mine, sp = 0u;
    for (;;) {
        sum = 0u; cnt = 0u; mine = 0u;
#pragma unroll
        for (unsigned j = 0; j < 16; ++j) { const unsigned c = xb_ld(&bar[XB_XCNT(j)]); sum += c; cnt += (c > 0u) ? 1u : 0u; mine = (j == x) ? c : mine; }
        if (sum == G) break;
        __builtin_amdgcn_s_sleep(1);
        if ((++sp & 255u) == 0u) { if (xb_ld(&bar[XB_TMO])) break; if (sp > XB_SPIN_CAP) { atomicAdd(&bar[XB_TMO], 1u); break; } }
    }
    nloc = mine > 0u ? mine : 1u; nx = cnt > 0u ? cnt : 1u;
}

__device__ __forceinline__ void xcd_barrier(const XcdBarrier& b) {
    asm volatile("s_waitcnt vmcnt(0)" ::: "memory");
    __syncthreads();
    if (threadIdx.x == 0) {
        unsigned* bar = b.bar;
        __builtin_amdgcn_s_waitcnt(0);
        unsigned nloc = b.st[0], nx = b.st[1];
        if (nloc == 0u) { xcd_barrier_complete(bar, b.x, nloc, nx); b.st[0] = nloc; b.st[1] = nx; }
        const unsigned old = xb_add(&bar[XB_XSUB(b.x)], 1u);
        const unsigned gen = old / nloc;
        if (old + 1u == (gen + 1u) * nloc) {
            __builtin_amdgcn_fence(__ATOMIC_RELEASE, "agent");
            asm volatile("s_waitcnt vmcnt(0)" ::: "memory");
            const unsigned og = xb_add(&bar[XB_TOP], 1u);
            const unsigned tg = og / nx;
            if (og + 1u == (tg + 1u) * nx) xb_add(&bar[XB_TOPGEN], 1u);
            else XB_SPIN(xb_ld(&bar[XB_TOPGEN]) == tg, bar);
            __builtin_amdgcn_fence(__ATOMIC_ACQUIRE, "agent");
            xb_add(&bar[XB_XGEN(b.x)], 1u);
            asm volatile("s_waitcnt vmcnt(0)" ::: "memory");
        } else {
            XB_SPIN(xb_ld(&bar[XB_XGEN(b.x)]) == gen, bar);
            __builtin_amdgcn_fence(__ATOMIC_ACQUIRE, "agent");
            asm volatile("s_waitcnt vmcnt(0)" ::: "memory");
        }
    }
    __syncthreads();
}
#define DI __device__ __forceinline__
typedef float f32x16 __attribute__((ext_vector_type(16)));
typedef unsigned u32x4 __attribute__((ext_vector_type(4)));
constexpr int NWAVES = 8, NTHREADS = 512;
constexpr int NB = 8, SEQ = 2048, DM = 1024, M_TOK = NB * SEQ, FF = 4096, DEPTH = 4, INW = 3224;
constexpr int N2 = 1280, N1 = 2048;
constexpr int NHEAD = 6, HD = 64, NCHUNK = SEQ / 64;
constexpr float LOG2E = 1.4426950408889634f;
constexpr float C2 = 0.17677669529663687f * 1.4426950408889634f;
constexpr int U2_GQ = 0, U2_GK = 384, U2_GV = 768, U2_BF = 1152, U2_BB = 1158, U2_AF = 1164, U2_AB = 1170;
constexpr int U1_DQ = 0, U1_DK = 384, U1_DV = 768, U1_GZ = 1152, U1_CA = 1536, U1_CG = 1792;
constexpr int Y_CONV = 0, Y_DIFF = 256, Y_DELTA = 640;
constexpr size_t MiB = 1u << 20;
constexpr size_t WS_CTL = 0, CTL_ZERO_BYTES = 1 * MiB;
constexpr size_t WS_WIN2 = 2 * MiB;
constexpr size_t WS_WIN1 = WS_WIN2 + (size_t)N2 * DM * 2;
constexpr size_t WS_WOUT = WS_WIN1 + (size_t)N1 * DM * 2;
constexpr size_t WS_WFF1 = WS_WOUT + (size_t)DM * DM * 2;
constexpr size_t WS_WFF2 = WS_WFF1 + (size_t)FF * DM * 2;
constexpr size_t WS_YH = 27 * MiB;
constexpr size_t WS_U = 59 * MiB;
constexpr size_t WS_CH = 123 * MiB;
constexpr size_t WS_OFB = 221 * MiB;
constexpr size_t WS_T = 59 * MiB;
constexpr size_t WS_HID = 128 * MiB;
constexpr size_t WS_END = 256 * MiB;
static_assert(WS_WFF2 + (size_t)DM * FF * 2 <= WS_YH && WS_YH + (size_t)M_TOK * DM * 2 <= WS_U && WS_U + (size_t)M_TOK * N1 * 2 <= WS_CH, "ws map 1");
constexpr size_t CH_UNIT = 66560, CH_QN = 0, CH_KNT = 8192, CH_DIR = 16384, CH_DIRSZ = 24576, CH_W = 0, CH_AQK = 8192, CH_UU = 16384, CH_VEC = 65536;
static_assert(WS_CH + (size_t)NB * NCHUNK * NHEAD * CH_UNIT <= WS_OFB && WS_OFB + 2 * (size_t)M_TOK * 384 * 2 <= WS_END && WS_T + (size_t)M_TOK * DM * 4 <= WS_HID && WS_HID + (size_t)M_TOK * FF * 2 <= WS_END, "ws map 2");
constexpr int CW_TMO = 0, CW_CODE = 1, CW_BAR = 4096;
constexpr int RING_BYTES = 131072, LDS_BYTES = 147456, LDSCTL_OFF = LDS_BYTES - 512, MISC_OFF = LDSCTL_OFF + 320;
static_assert(33600 * 4 <= LDSCTL_OFF && MISC_OFF + 128 <= LDS_BYTES, "LDS map");
DI float bf2f(unsigned b) { return __uint_as_float(b << 16); }
template <int K> DI float xshfl(float v) { return __int_as_float(__builtin_amdgcn_ds_swizzle(__float_as_int(v), 0x1f | (K << 10))); }
DI float half_sum(float v) { auto rr = __builtin_amdgcn_permlane32_swap(__float_as_uint(v), __float_as_uint(v), false, false); return __uint_as_float(rr[0]) + __uint_as_float(rr[1]); }
DI float half_max(float v) { auto rr = __builtin_amdgcn_permlane32_swap(__float_as_uint(v), __float_as_uint(v), false, false); return fmaxf(__uint_as_float(rr[0]), __uint_as_float(rr[1])); }
DI float wave_sum(float v) { v += xshfl<1>(v); v += xshfl<2>(v); v += xshfl<4>(v); v += xshfl<8>(v); v += xshfl<16>(v); return half_sum(v); }
DI float wave_max(float v) { v = fmaxf(v, xshfl<1>(v)); v = fmaxf(v, xshfl<2>(v)); v = fmaxf(v, xshfl<4>(v)); v = fmaxf(v, xshfl<8>(v)); v = fmaxf(v, xshfl<16>(v)); return half_max(v); }
DI float sigmoidf_(float x) { return 1.f / (1.f + __expf(-x)); }
DI float siluf_(float x) { return x / (1.f + __expf(-x)); }
DI float softplusf_(float x) { return fmaxf(x, 0.f) + log1pf(__expf(-fabsf(x))); }
DI void unpack8(const v4u r, float (&f)[8]) {
    f[0] = bf2f(r.x & 0xffffu); f[1] = bf2f(r.x >> 16); f[2] = bf2f(r.y & 0xffffu); f[3] = bf2f(r.y >> 16);
    f[4] = bf2f(r.z & 0xffffu); f[5] = bf2f(r.z >> 16); f[6] = bf2f(r.w & 0xffffu); f[7] = bf2f(r.w >> 16);
}
DI v4u pack8(const float (&f)[8]) { v4u o; o.x = pk2(f[0], f[1]); o.y = pk2(f[2], f[3]); o.z = pk2(f[4], f[5]); o.w = pk2(f[6], f[7]); return o; }

struct Args { const float* in[22]; float* out; unsigned char* ws; int ph_lo, ph_hi; };
struct Ctx {
    LAS unsigned char* lds;
    int tid, lane, wave, G, gw, NGW;
    const Args* a;
    DI const float* in(int i) const { return a->in[i]; }
    DI float* out() const { return a->out; }
    DI unsigned char* ws() const { return a->ws; }
    DI bf16* Win2() const { return (bf16*)(a->ws + WS_WIN2); }
    DI bf16* Win1() const { return (bf16*)(a->ws + WS_WIN1); }
    DI bf16* Wout() const { return (bf16*)(a->ws + WS_WOUT); }
    DI bf16* Wff1() const { return (bf16*)(a->ws + WS_WFF1); }
    DI bf16* Wff2() const { return (bf16*)(a->ws + WS_WFF2); }
    DI bf16* YH() const { return (bf16*)(a->ws + WS_YH); }
    DI bf16* U() const { return (bf16*)(a->ws + WS_U); }
    DI bf16* OF() const { return (bf16*)(a->ws + WS_OFB); }
    DI bf16* OB() const { return (bf16*)(a->ws + WS_OFB) + (size_t)M_TOK * 384; }
    DI bf16* HID() const { return (bf16*)(a->ws + WS_HID); }
    DI float* T() const { return (float*)(a->ws + WS_T); }
    DI unsigned char* CH() const { return a->ws + WS_CH; }
};

DI int src_col(int which, int n, float& sc) {
    sc = 1.f;
    if (which == 0) { if (n < 1152) return n + 1664; if (n < 1176) return n + 2048; return -1; }
    if (which == 1) { if (n < 384) sc = C2; if (n < 1152) return n + 512; if (n < 1536) return n + 1664; return n - 1536; }
    return n;
}
DI void convert_item(const float* W, int K, int Nsrc, bf16* WT, int which, int nblk, int item, LAS float* scr, int lane) {
    const int kb = item / nblk, nb = item % nblk, k0 = 64 * kb, n0 = 32 * nb;
    float sc; const int src = src_col(which, n0 + (lane & 31), sc);
#pragma unroll 8
    for (int i = 0; i < 32; ++i) { const int kk = 2 * i + (lane >> 5); scr[kk * 33 + (lane & 31)] = (src >= 0) ? W[(size_t)(k0 + kk) * Nsrc + src] * sc : 0.f; }
    LDS_WAIT(); asm volatile("" ::: "memory");
    const int c = lane & 7;
#pragma unroll
    for (int j = 0; j < 4; ++j) { const int n = (lane >> 3) + 8 * j; const LAS float* s = scr + (8 * c) * 33 + n;
        v4u o; o.x = pk2(s[0 * 33], s[1 * 33]); o.y = pk2(s[2 * 33], s[3 * 33]); o.z = pk2(s[4 * 33], s[5 * 33]); o.w = pk2(s[6 * 33], s[7 * 33]);
        *(GAS v4u*)(WT + (size_t)(n0 + n) * K + k0 + 8 * c) = o; }
    LDS_WAIT(); asm volatile("" ::: "memory");
}
DI void convert_layer(const Ctx& C, int l) {
    LAS float* scr = (LAS float*)(C.lds + C.wave * 16384);
    constexpr int I2 = (DM / 64) * (N2 / 32), I1 = (DM / 64) * (N1 / 32), IO = (DM / 64) * (DM / 32), IF1 = (DM / 64) * (FF / 32), IF2 = (FF / 64) * (DM / 32);
    const float* win = C.in(1) + (size_t)l * DM * INW; const float* wout = C.in(2) + (size_t)l * DM * DM;
    const float* wf1 = C.in(7) + (size_t)l * DM * FF; const float* wf2 = C.in(8) + (size_t)l * FF * DM;
    for (int it = C.gw; it < I2 + I1 + IO + IF1 + IF2; it += C.NGW) {
        int r = it;
        if (r < I2) { convert_item(win, DM, INW, C.Win2(), 0, N2 / 32, r, scr, C.lane); continue; } r -= I2;
        if (r < I1) { convert_item(win, DM, INW, C.Win1(), 1, N1 / 32, r, scr, C.lane); continue; } r -= I1;
        if (r < IO) { convert_item(wout, DM, DM, C.Wout(), 2, DM / 32, r, scr, C.lane); continue; } r -= IO;
        if (r < IF1) { convert_item(wf1, DM, FF, C.Wff1(), 2, FF / 32, r, scr, C.lane); continue; } r -= IF1;
        convert_item(wf2, FF, DM, C.Wff2(), 2, DM / 32, r, scr, C.lane);
    }
}
DI void rowwise(const Ctx& C, const float* t, const float* xin, float* xout, const float* wpost, const float* wpre, bf16* hn) {
    for (int row = C.gw; row < M_TOK; row += C.NGW) {
        const GAS f32x4* xr = (const GAS f32x4*)(xin + (size_t)row * DM) + C.lane;
        f32x4 v[4];
#pragma unroll
        for (int j = 0; j < 4; ++j) v[j] = xr[64 * j];
        if (t) {
            const GAS f32x4* tr = (const GAS f32x4*)(t + (size_t)row * DM) + C.lane; f32x4 tv[4]; float s = 0.f;
#pragma unroll
            for (int j = 0; j < 4; ++j) { tv[j] = tr[64 * j]; s += (tv[j].x * tv[j].x + tv[j].y * tv[j].y) + (tv[j].z * tv[j].z + tv[j].w * tv[j].w); }
            const float r = rsqrtf(wave_sum(s) * (1.f / DM) + 1e-6f);
#pragma unroll
            for (int j = 0; j < 4; ++j) { const f32x4 w = *((const GAS f32x4*)wpost + C.lane + 64 * j); v[j] = v[j] + tv[j] * r * w; }
        }
        if (t || xout != xin) { GAS f32x4* xo = (GAS f32x4*)(xout + (size_t)row * DM) + C.lane;
#pragma unroll
            for (int j = 0; j < 4; ++j) xo[64 * j] = v[j]; }
        if (wpre) {
            float s = 0.f;
#pragma unroll
            for (int j = 0; j < 4; ++j) s += (v[j].x * v[j].x + v[j].y * v[j].y) + (v[j].z * v[j].z + v[j].w * v[j].w);
            const float r = rsqrtf(wave_sum(s) * (1.f / DM) + 1e-6f);
            GAS unsigned long long* o8 = (GAS unsigned long long*)(hn + (size_t)row * DM) + C.lane;
#pragma unroll
            for (int j = 0; j < 4; ++j) { const f32x4 w = *((const GAS f32x4*)wpre + C.lane + 64 * j); const f32x4 o = v[j] * r * w;
                o8[64 * j] = (unsigned long long)pk2(o.x, o.y) | ((unsigned long long)pk2(o.z, o.w) << 32); }
        }
    }
}
template <int MODE  > DI void gemm_simple(const Ctx& C, const bf16* A, const bf16* Bt, int N, int K, void* out, int ldc) {
    const int r = C.lane & 31, h = C.lane >> 5, tn = N / 64, tiles = (M_TOK / 64) * tn;
    for (int t = C.gw; t < tiles; t += C.NGW) {
        const int m0 = (t / tn) * 64, n0 = (t % tn) * 64;
        f32x16 acc[2][2];
#pragma unroll
        for (int i = 0; i < 2; ++i)
#pragma unroll
            for (int j = 0; j < 2; ++j)
#pragma unroll
                for (int e = 0; e < 16; ++e) acc[i][j][e] = 0.f;
        const bf16* ap = A + (size_t)(m0 + r) * K + 8 * h; const bf16* bp = Bt + (size_t)(n0 + r) * K + 8 * h;
        for (int k0 = 0; k0 < K; k0 += 16) {
            bf16x8 a[2], b[2];
#pragma unroll
            for (int i = 0; i < 2; ++i) { a[i] = *(const bf16x8*)(ap + (size_t)(32 * i) * K + k0); b[i] = *(const bf16x8*)(bp + (size_t)(32 * i) * K + k0); }
#pragma unroll
            for (int i = 0; i < 2; ++i)
#pragma unroll
                for (int j = 0; j < 2; ++j) acc[i][j] = __builtin_amdgcn_mfma_f32_32x32x16_bf16(a[i], b[j], acc[i][j], 0, 0, 0);
        }
#pragma unroll
        for (int i = 0; i < 2; ++i)
#pragma unroll
            for (int j = 0; j < 2; ++j)
#pragma unroll
                for (int e = 0; e < 16; ++e) {
                    const int row = m0 + 32 * i + (e & 3) + 8 * (e >> 2) + 4 * h, col = n0 + 32 * j + r; float v = acc[i][j][e];
                    if (MODE == 2) ((float*)out)[(size_t)row * ldc + col] = v;
                    else { if (MODE == 1) { v = fmaxf(v, 0.f); v = v * v; } ((bf16*)out)[(size_t)row * ldc + col] = (bf16)f2bf(v); }
                }
    }
}
DI void conv_phase(const Ctx& C, int l) {
    LAS float* glu = (LAS float*)C.lds;
    LAS float* st = (LAS float*)(C.lds + 94 * 256 * 4);
    const float* dww = C.in(9) + (size_t)l * 31 * 256; const float* dwb = C.in(10) + l * 256; const float* lnw = C.in(11) + l * 256; const float* lnb = C.in(12) + l * 256;
    for (int unit = blockIdx.x; unit < M_TOK / 64; unit += C.G) {
        const int b = unit / NCHUNK, n = unit % NCHUNK, p0 = n * 64 - 15;
        for (int idx = C.tid; idx < 94 * 32; idx += NTHREADS) {
            const int rr = idx >> 5, c8 = (idx & 31) * 8, p = p0 + rr;
            float o[8];
            if (p >= 0 && p < SEQ) {
                const bf16* row = C.U() + (size_t)(b * SEQ + p) * N1;
                const v4u av = *(const GAS v4u*)(row + U1_CA + c8), gv = *(const GAS v4u*)(row + U1_CG + c8);
                float a[8], g[8]; unpack8(av, a); unpack8(gv, g);
#pragma unroll
                for (int e = 0; e < 8; ++e) o[e] = a[e] * sigmoidf_(g[e]);
            } else {
#pragma unroll
                for (int e = 0; e < 8; ++e) o[e] = 0.f;
            }
            *(LAS f32x4*)(glu + rr * 256 + c8) = (f32x4){o[0], o[1], o[2], o[3]}; *(LAS f32x4*)(glu + rr * 256 + c8 + 4) = (f32x4){o[4], o[5], o[6], o[7]};
        }
        __syncthreads();
        const int c = C.tid & 255, half = C.tid >> 8, wq = C.wave & 3;
        float w[31];
#pragma unroll
        for (int j = 0; j < 31; ++j) w[j] = dww[j * 256 + c];
        const float bias = dwb[c];
        for (int i = 0; i < 32; ++i) {
            const int tt = half * 32 + i; float hv = bias;
#pragma unroll
            for (int j = 0; j < 31; ++j) hv += w[j] * glu[(tt + j) * 256 + c];
            const float s = wave_sum(hv), q = wave_sum(hv * hv);
            if (C.lane == 0) { st[(tt * 4 + wq) * 2] = s; st[(tt * 4 + wq) * 2 + 1] = q; }
        }
        __syncthreads();
        const float gw_ = lnw[c], gb_ = lnb[c];
        for (int i = 0; i < 32; ++i) {
            const int tt = half * 32 + i; float hv = bias;
#pragma unroll
            for (int j = 0; j < 31; ++j) hv += w[j] * glu[(tt + j) * 256 + c];
            const float s = (st[(tt * 4) * 2] + st[(tt * 4 + 1) * 2]) + (st[(tt * 4 + 2) * 2] + st[(tt * 4 + 3) * 2]);
            const float q = (st[(tt * 4) * 2 + 1] + st[(tt * 4 + 1) * 2 + 1]) + (st[(tt * 4 + 2) * 2 + 1] + st[(tt * 4 + 3) * 2 + 1]);
            const float mean = s * (1.f / 256.f), var = fmaxf(q * (1.f / 256.f) - mean * mean, 0.f), r = rsqrtf(var + 1e-5f);
            const float v = (hv - mean) * r * gw_ + gb_;
            C.YH()[(size_t)(b * SEQ + n * 64 + tt) * DM + Y_CONV + c] = (bf16)f2bf(siluf_(v));
        }
        __syncthreads();
    }
}
DI int afrag_off(int row, int k) { return ((row >> 5) * 4 + (k >> 4)) * 1024 + ((((k >> 2) & 1) * 32 + (row & 31)) * 16) + (((k >> 3) & 1) * 8) + (k & 3) * 2; }
DI int dimg_off(int c, int dv) { return (((dv >> 5) * 2 + (c >> 5)) * 64 + ((c >> 2) & 1) * 32 + (dv & 31)) * 32 + ((c & 3) | (((c >> 3) & 3) << 2)) * 2; }
DI void st_afrag(unsigned char* img, int row, int k8, const v4u v) {
    typedef unsigned u32x2_t __attribute__((ext_vector_type(2)));
    *(GAS u32x2_t*)(img + afrag_off(row, k8)) = (u32x2_t){v.x, v.y}; *(GAS u32x2_t*)(img + afrag_off(row, k8 + 4)) = (u32x2_t){v.z, v.w};
}
DI void delta_prep(const Ctx& C, int l) {
    LAS float* L = (LAS float*)C.lds;
    LAS float *qf = L, *kf = L + 4160, *vf = L + 8320, *ar = L + 12480, *qkr = L + 16640, *ad = L + 20800, *xx = L + 24960, *gt = L + 33216;
    const float* dcw = C.in(18) + (size_t)l * 3 * 1152; const float* alog = C.in(19) + l * 12; const float* dtb = C.in(20) + l * 12;
    for (int unit = blockIdx.x; unit < NB * NCHUNK * NHEAD; unit += C.G) {
        const int h = unit % NHEAD, bn = unit / NHEAD, n = bn % NCHUNK, b = bn / NCHUNK;
        const size_t t0 = (size_t)b * SEQ + n * 64;
        unsigned char* chb = C.CH() + (size_t)unit * CH_UNIT;
        {   const int c = C.tid >> 3, d8 = (C.tid & 7) * 8;
#pragma unroll
            for (int part = 0; part < 3; ++part) {
                const int col = U2_GQ + part * 384 + h * 64 + d8, wch = part * 384 + h * 64 + d8;
                float acc[8];
#pragma unroll
                for (int e = 0; e < 8; ++e) acc[e] = 0.f;
#pragma unroll
                for (int j = 0; j < 3; ++j) { const int p = n * 64 + c + j - 1;
                    if (p >= 0 && p < SEQ) { const v4u r = *(const GAS v4u*)(C.U() + (size_t)(b * SEQ + p) * N2 + col); float f[8]; unpack8(r, f);
#pragma unroll
                        for (int e = 0; e < 8; ++e) acc[e] += dcw[j * 1152 + wch + e] * f[e]; } }
#pragma unroll
                for (int e = 0; e < 8; ++e) acc[e] = siluf_(acc[e]);
                if (part < 2) { float ss = 0.f;
#pragma unroll
                    for (int e = 0; e < 8; ++e) ss += acc[e] * acc[e];
                    ss += xshfl<1>(ss); ss += xshfl<2>(ss); ss += xshfl<4>(ss);
                    const float sc = rsqrtf(ss + 1e-6f) * (part == 0 ? 0.125f : 1.f);
#pragma unroll
                    for (int e = 0; e < 8; ++e) acc[e] *= sc; }
                LAS float* dst = (part == 0 ? qf : part == 1 ? kf : vf) + c * 65 + d8;
#pragma unroll
                for (int e = 0; e < 8; ++e) dst[e] = acc[e];
            }
        }
        if (C.tid < 64) { const int c = C.tid; const bf16* row = C.U() + (t0 + c) * N2;
            gt[128 + c] = sigmoidf_(bf2f(row[U2_BF + h])); gt[192 + c] = sigmoidf_(bf2f(row[U2_BB + h]));
            gt[c] = -__expf(alog[h]) * softplusf_(bf2f(row[U2_AF + h]) + dtb[h]); gt[64 + c] = -__expf(alog[6 + h]) * softplusf_(bf2f(row[U2_AB + h]) + dtb[6 + h]); }
        __syncthreads();
        if (C.tid == 0) { float s = 0.f; for (int c = 0; c < 64; ++c) { s += gt[c]; gt[256 + c] = s; } }
        if (C.tid == 64) { float s = 0.f; for (int c = 63; c >= 0; --c) { s += gt[64 + c]; gt[320 + c] = s; } }
        for (int i = 0; i < 8; ++i) { const int idx = C.tid + 512 * i, c = idx >> 6, s = idx & 63; float a = 0.f, q = 0.f;
            for (int d = 0; d < 64; ++d) { const float kd = kf[s * 65 + d]; a += kf[c * 65 + d] * kd; q += qf[c * 65 + d] * kd; }
            ar[c * 65 + s] = a; qkr[c * 65 + s] = q; }
        {   const int c = C.tid >> 3, d8 = (C.tid & 7) * 8; float f[8];
#pragma unroll
            for (int e = 0; e < 8; ++e) f[e] = qf[c * 65 + d8 + e];
            st_afrag(chb + CH_QN, c, d8, pack8(f));
#pragma unroll
            for (int e = 0; e < 8; ++e) f[e] = kf[(d8 + e) * 65 + c];
            st_afrag(chb + CH_KNT, c, d8, pack8(f));
        }
        __syncthreads();
        for (int dir = 0; dir < 2; ++dir) {
            LAS float* gc = gt + 256 + 64 * dir; LAS float* be = gt + 128 + 64 * dir;
            for (int i = 0; i < 8; ++i) { const int idx = C.tid + 512 * i, c = idx >> 6, s = idx & 63; const bool strict = dir ? (c < s) : (c > s);
                ad[c * 65 + s] = strict ? be[c] * ar[c * 65 + s] * __expf(gc[c] - gc[s]) : 0.f; }
            for (int i = 0; i < 16; ++i) { const int idx = C.tid + 512 * i, c = idx >> 7, col = idx & 127;
                xx[c * 129 + col] = (col < 64) ? be[c] * vf[c * 65 + col] : be[c] * kf[c * 65 + col - 64] * __expf(gc[c]); }
            __syncthreads();
            if (C.tid < 128) { const int col = C.tid;
                if (dir == 0) { for (int c = 1; c < 64; ++c) { float acc = xx[c * 129 + col]; for (int s = 0; s < c; ++s) acc -= ad[c * 65 + s] * xx[s * 129 + col]; xx[c * 129 + col] = acc; } }
                else { for (int c = 62; c >= 0; --c) { float acc = xx[c * 129 + col]; for (int s = c + 1; s < 64; ++s) acc -= ad[c * 65 + s] * xx[s * 129 + col]; xx[c * 129 + col] = acc; } } }
            __syncthreads();
            unsigned char* db = chb + CH_DIR + (size_t)dir * CH_DIRSZ;
            {   const int c = C.tid >> 3, d8 = (C.tid & 7) * 8; float f[8];
#pragma unroll
                for (int e = 0; e < 8; ++e) f[e] = xx[c * 129 + d8 + e];
#pragma unroll
                for (int e = 0; e < 8; ++e) *(bf16*)(db + CH_UU + dimg_off(c, d8 + e)) = (bf16)f2bf(f[e]);
#pragma unroll
                for (int e = 0; e < 8; ++e) f[e] = -xx[c * 129 + 64 + d8 + e];
                st_afrag(db + CH_W, c, d8, pack8(f));
#pragma unroll
                for (int e = 0; e < 8; ++e) { const int s = d8 + e; const bool incl = dir ? (c <= s) : (c >= s); f[e] = incl ? qkr[c * 65 + s] * __expf(gc[c] - gc[s]) : 0.f; }
                st_afrag(db + CH_AQK, c, d8, pack8(f));
            }
            if (C.tid < 64) { const float gl = dir ? gc[0] : gc[63]; float* vec = (float*)(chb + CH_VEC + dir * 512); vec[C.tid] = __expf(gc[C.tid]); vec[64 + C.tid] = __expf(gl - gc[C.tid]); }
            __syncthreads();
        }
    }
}
DI void delta_finish(const Ctx& C, int l) {
    const float w = C.in(21)[l * 64 + C.lane];
    for (int row = C.gw; row < M_TOK; row += C.NGW) {
#pragma unroll
        for (int h = 0; h < NHEAD; ++h) {
            const float o = bf2f(C.OF()[(size_t)row * 384 + h * 64 + C.lane]) + bf2f(C.OB()[(size_t)row * 384 + h * 64 + C.lane]);
            const float r = rsqrtf(wave_sum(o * o) * (1.f / 64.f) + 1e-6f);
            const float z = bf2f(C.U()[(size_t)row * N1 + U1_GZ + h * 64 + C.lane]);
            C.YH()[(size_t)row * DM + Y_DELTA + h * 64 + C.lane] = (bf16)f2bf(o * r * w * siluf_(z));
        }
    }
}
DI float alibi_slope(int h) { return h == 0 ? 0.25f : h == 1 ? 0.0625f : h == 2 ? 0.015625f : h == 3 ? 0.00390625f : h == 4 ? 0.5f : 0.125f; }
DI float diff_lambda(const Ctx& C, int l, float& linit) {
    const float a = (C.lane < 32) ? C.in(13)[l * 32 + (C.lane & 31)] * C.in(14)[l * 32 + (C.lane & 31)] : 0.f;
    const float b = (C.lane < 32) ? C.in(15)[l * 32 + (C.lane & 31)] * C.in(16)[l * 32 + (C.lane & 31)] : 0.f;
    linit = 0.8f - 0.6f * expf(-0.3f * (float)l);
    return expf(wave_sum(a)) - expf(wave_sum(b)) + linit;
}
DI void attn_simple(const Ctx& C, int l) {
    LAS float* sc = (LAS float*)C.lds + C.wave * 2048;
    float linit; const float lam = diff_lambda(C, l, linit);
    const float sw = C.in(17)[l * 64 + C.lane] * (1.f - linit);
    for (int unit = blockIdx.x; unit < NB * NHEAD * (SEQ / 8); unit += C.G) {
        const int bh = unit / (SEQ / 8), qi = (unit % (SEQ / 8)) * 8 + C.wave, b = bh / NHEAD, h = bh % NHEAD;
        const float slope2 = alibi_slope(h) * LOG2E;
        const size_t tq = (size_t)b * SEQ + qi;
        float o[2];
#pragma unroll
        for (int m = 0; m < 2; ++m) {
            const bf16* qp = C.U() + tq * N1 + U1_DQ + h * 64 + m * 32;
            float qv[32];
#pragma unroll
            for (int j = 0; j < 4; ++j) { float f[8]; unpack8(*(const GAS v4u*)(qp + 8 * j), f);
#pragma unroll
                for (int e = 0; e < 8; ++e) qv[8 * j + e] = f[e]; }
            float mx = -INFINITY;
            for (int kb = 0; kb < SEQ / 64; ++kb) {
                const int key = kb * 64 + C.lane; const bf16* kp = C.U() + (size_t)(b * SEQ + key) * N1 + U1_DK + h * 64 + m * 32; float dot = 0.f;
#pragma unroll
                for (int j = 0; j < 4; ++j) { float f[8]; unpack8(*(const GAS v4u*)(kp + 8 * j), f);
#pragma unroll
                    for (int e = 0; e < 8; ++e) dot += qv[8 * j + e] * f[e]; }
                const float s = dot - slope2 * fabsf((float)(qi - key)); sc[key] = s; mx = fmaxf(mx, s);
            }
            mx = wave_max(mx);
            float sum = 0.f;
            for (int kb = 0; kb < SEQ / 64; ++kb) { const int key = kb * 64 + C.lane; const float p = exp2f(sc[key] - mx); sc[key] = p; sum += p; }
            sum = wave_sum(sum);
            LDS_WAIT(); asm volatile("" ::: "memory");
            const bf16* vp = C.U() + (size_t)b * SEQ * N1 + U1_DV + h * 64 + C.lane; float acc = 0.f;
#pragma unroll 8
            for (int key = 0; key < SEQ; ++key) acc += sc[key] * bf2f(vp[(size_t)key * N1]);
            o[m] = acc / sum;
            LDS_WAIT(); asm volatile("" ::: "memory");
        }
        const float a = o[0] - lam * o[1];
        const float r = rsqrtf(wave_sum(a * a) * (1.f / 64.f) + 1e-5f);
        C.YH()[tq * DM + Y_DIFF + h * 64 + C.lane] = (bf16)f2bf(a * r * sw);
    }
}
namespace dattn {
typedef short s16x4 __attribute__((ext_vector_type(4)));
typedef float f32x2_t __attribute__((ext_vector_type(2))); typedef __bf16 bf16x2_t __attribute__((ext_vector_type(2)));
constexpr int SLOT = 8192, LDS_K = 0, LDS_V = 3 * SLOT, LDS_WS = 6 * SLOT, LDS_OST = LDS_WS + 2048, OST_LD = 68;
constexpr float THR = 8.f;
DI int crow(int r, int hi) { return (r & 3) + 8 * (r >> 2) + 4 * hi; }
DI unsigned cvtpk(float lo, float hi) { f32x2_t v = {lo, hi}; bf16x2_t b = __builtin_convertvector(v, bf16x2_t); return __builtin_bit_cast(unsigned, b); }
DI s16x4 vtr(const LAS unsigned char* p) { return __builtin_bit_cast(s16x4, __builtin_amdgcn_ds_read_tr16_b64_v4i16((LAS s16x4*)p)); }
DI void glds(const bf16* g, LAS unsigned char* l) { unsigned keep; const unsigned dst = (unsigned)__builtin_amdgcn_readfirstlane((int)(unsigned)(uintptr_t)l);
    asm volatile("s_mov_b32 %0, m0\n\ts_mov_b32 m0, %2\n\ts_nop 0\n\tglobal_load_lds_dwordx4 %1, off\n\ts_mov_b32 m0, %0" : "=&s"(keep) : "v"(g), "s"(dst) : "memory"); }
DI float pl_max(float v) { auto rr = __builtin_amdgcn_permlane32_swap(__float_as_uint(v), __float_as_uint(v), false, false); return fmaxf(__uint_as_float(rr[0]), __uint_as_float(rr[1])); }
DI float pl_sum(float v) { auto rr = __builtin_amdgcn_permlane32_swap(__float_as_uint(v), __float_as_uint(v), false, false); return __uint_as_float(rr[0]) + __uint_as_float(rr[1]); }
}
DI void attn_phase(const Ctx& C, int l) {
    using namespace dattn;
    const int lane = C.lane, r32 = lane & 31, hi = lane >> 5, w = C.wave, map = w >> 2, wq = w & 3;
    float linit; const float lam = diff_lambda(C, l, linit);
    LAS unsigned char* L = C.lds;
    const bf16* U = C.U();
    const int vcu = (C.G % 8 == 0) ? ((int)blockIdx.x % 8) * (C.G / 8) + (int)blockIdx.x / 8 : (int)blockIdx.x;
    for (int unit = vcu; unit < NB * NHEAD * (SEQ / 128); unit += C.G) {
        const int bh = unit >> 4, qb = unit & 15, b = bh / NHEAD, h = bh % NHEAD;
        const float slope2 = alibi_slope(h) * LOG2E;
        const size_t rowbase = (size_t)b * SEQ;
        const int q0 = qb * 128 + wq * 32;
        const bf16* ksrc = U + (rowbase + lane) * N1 + U1_DK + h * 64 + w * 8;
        const bf16* vsrc = U + (rowbase + 16 * (w & 3) + (lane >> 2)) * N1 + U1_DV + h * 64 + (w >> 2) * 32 + (lane & 3) * 8;
#define DATTN_DMA(t, slot) do { glds(ksrc + (size_t)(t) * 64 * N1, L + LDS_K + (slot) * SLOT + w * 1024); glds(vsrc + (size_t)(t) * 64 * N1, L + LDS_V + (slot) * SLOT + w * 1024); } while (0)
        DATTN_DMA(0, 0); DATTN_DMA(1, 1);
        bf16x8 qr[2];
#pragma unroll
        for (int d0 = 0; d0 < 2; ++d0) qr[d0] = *(const bf16x8*)(U + (rowbase + q0 + r32) * N1 + U1_DQ + h * 64 + map * 32 + d0 * 16 + hi * 8);
        asm volatile("" : "+v"(qr[0]), "+v"(qr[1]));
        float m = -INFINITY, lsum = 0.f;
        f32x16 o[2];
#pragma unroll
        for (int e = 0; e < 16; ++e) { o[0][e] = 0.f; o[1][e] = 0.f; }
        const float qposf = (float)(q0 + r32);
        LAS float* wsf = (LAS float*)(L + LDS_WS) + w * 64;
        for (int t = 0; t < SEQ / 64; ++t) {
            const int slot = t % 3;
            asm volatile("s_waitcnt vmcnt(2)" ::: "memory"); __builtin_amdgcn_s_barrier(); asm volatile("" ::: "memory");
            { const int t2 = (t + 2) & 31, s2 = (t + 2) % 3; DATTN_DMA(t2, s2); }
            const LAS unsigned char* kb = L + LDS_K + slot * SLOT + (4 * map + hi) * 1024 + r32 * 16;
            const bf16x8 k00 = *(const LAS bf16x8*)(kb), k10 = *(const LAS bf16x8*)(kb + 512), k01 = *(const LAS bf16x8*)(kb + 2048), k11 = *(const LAS bf16x8*)(kb + 2048 + 512);
            f32x16 p0, p1;
#pragma unroll
            for (int e = 0; e < 16; ++e) { p0[e] = 0.f; p1[e] = 0.f; }
            p0 = __builtin_amdgcn_mfma_f32_32x32x16_bf16(k00, qr[0], p0, 0, 0, 0); p1 = __builtin_amdgcn_mfma_f32_32x32x16_bf16(k10, qr[0], p1, 0, 0, 0);
            p0 = __builtin_amdgcn_mfma_f32_32x32x16_bf16(k01, qr[1], p0, 0, 0, 0); p1 = __builtin_amdgcn_mfma_f32_32x32x16_bf16(k11, qr[1], p1, 0, 0, 0);
            const float base = (float)(t * 64 + 4 * hi) - qposf;
#pragma unroll
            for (int r = 0; r < 16; ++r) { const float c = (float)((r & 3) + 8 * (r >> 2));
                p0[r] = fmaf(-slope2, fabsf(base + c), p0[r]); p1[r] = fmaf(-slope2, fabsf(base + (c + 32.f)), p1[r]); }
            float rm = fmaxf(p0[0], p1[0]);
#pragma unroll
            for (int r = 1; r < 16; ++r) rm = fmaxf(rm, fmaxf(p0[r], p1[r]));
            rm = pl_max(rm);
            if (__any(rm > m + THR)) {
                const float mn = fmaxf(m, rm), f = __builtin_amdgcn_exp2f(m - mn);
                lsum *= f; m = mn;
                if (hi == 0) wsf[r32] = f;
                asm volatile("s_waitcnt lgkmcnt(0)" ::: "memory");
#pragma unroll
                for (int r = 0; r < 16; ++r) { const float fr_ = wsf[crow(r, hi)]; o[0][r] *= fr_; o[1][r] *= fr_; }
            }
            float sacc = 0.f;
#pragma unroll
            for (int r = 0; r < 16; ++r) { p0[r] = __builtin_amdgcn_exp2f(p0[r] - m); p1[r] = __builtin_amdgcn_exp2f(p1[r] - m); sacc += p0[r] + p1[r]; }
            lsum += sacc;
            u32x4 pw[4];
#pragma unroll
            for (int i = 0; i < 4; ++i) { pw[0][i] = cvtpk(p0[2 * i], p0[2 * i + 1]); pw[1][i] = cvtpk(p0[8 + 2 * i], p0[9 + 2 * i]); pw[2][i] = cvtpk(p1[2 * i], p1[2 * i + 1]); pw[3][i] = cvtpk(p1[8 + 2 * i], p1[9 + 2 * i]); }
            const LAS unsigned char* vp = L + LDS_V + slot * SLOT + ((lane >> 4) & 1) * 32 + (lane & 3) * 8 + (4 * hi + ((lane & 15) >> 2)) * 64;
#pragma unroll
            for (int d0h = 0; d0h < 2; ++d0h)
#pragma unroll
                for (int ks = 0; ks < 4; ++ks) {
                    const s16x4 lo = vtr(vp + d0h * 4096 + ks * 1024), hh = vtr(vp + d0h * 4096 + ks * 1024 + 512);
                    const bf16x8 vf = (bf16x8){lo[0], lo[1], lo[2], lo[3], hh[0], hh[1], hh[2], hh[3]};
                    o[d0h] = __builtin_amdgcn_mfma_f32_32x32x16_bf16(__builtin_bit_cast(bf16x8, pw[ks]), vf, o[d0h], 0, 0, 0);
                }
        }
#undef DATTN_DMA
        asm volatile("s_waitcnt vmcnt(0)" ::: "memory"); __builtin_amdgcn_s_barrier(); asm volatile("" ::: "memory");
        lsum = pl_sum(lsum);
        if (hi == 0) wsf[r32] = 1.f / lsum;
        asm volatile("s_waitcnt lgkmcnt(0)" ::: "memory");
        LAS float* ost = (LAS float*)(L + LDS_OST) + map * 128 * OST_LD;
#pragma unroll
        for (int r = 0; r < 16; ++r) { const int row = wq * 32 + crow(r, hi); const float rl = wsf[crow(r, hi)];
            ost[row * OST_LD + r32] = o[0][r] * rl; ost[row * OST_LD + 32 + r32] = o[1][r] * rl; }
        __syncthreads();
        {   const int row = C.tid >> 2, qd = (C.tid & 3) * 16;
            const LAS float* o1 = (const LAS float*)(L + LDS_OST) + row * OST_LD + qd; const LAS float* o2 = o1 + 128 * OST_LD;
            float a[16]; float ss = 0.f;
#pragma unroll
            for (int j = 0; j < 16; ++j) { a[j] = o1[j] - lam * o2[j]; ss += a[j] * a[j]; }
            ss += xshfl<1>(ss); ss += xshfl<2>(ss);
            const float rr = rsqrtf(ss * (1.f / 64.f) + 1e-5f) * (1.f - linit);
            const float* sw = C.in(17) + l * 64 + qd;
            float f0[8], f1[8];
#pragma unroll
            for (int j = 0; j < 8; ++j) { f0[j] = a[j] * rr * sw[j]; f1[j] = a[8 + j] * rr * sw[8 + j]; }
            bf16* yp = C.YH() + (rowbase + qb * 128 + row) * DM + Y_DIFF + h * 64 + qd;
            *(GAS v4u*)yp = pack8(f0); *(GAS v4u*)(yp + 8) = pack8(f1);
        }
        __syncthreads();
    }
}
namespace dscan {
constexpr int SLOTB = 41984, S_QN = 0, S_KNT = 8192, S_W = 16384, S_AQK = 24576, S_UU = 32768, S_VEC = 40960;
static_assert(3 * SLOTB <= LDSCTL_OFF, "scan ring");
DI bf16x8 pack8f(float a0, float a1, float a2, float a3, float a4, float a5, float a6, float a7) {
    u32x4 p; p.x = dattn::cvtpk(a0, a1); p.y = dattn::cvtpk(a2, a3); p.z = dattn::cvtpk(a4, a5); p.w = dattn::cvtpk(a6, a7); return __builtin_bit_cast(bf16x8, p); }
DI bf16x8 pack_step(const f32x16& x, int s) { return pack8f(x[8 * s], x[8 * s + 1], x[8 * s + 2], x[8 * s + 3], x[8 * s + 4], x[8 * s + 5], x[8 * s + 6], x[8 * s + 7]); }
}
DI void scan_phase(const Ctx& C) {
    using namespace dscan;
    const int lane = C.lane, r32 = lane & 31, hi = lane >> 5, w = C.wave;
    LAS unsigned char* L = C.lds;
    for (int unit = blockIdx.x; unit < NB * NHEAD * 2; unit += C.G) {
        const int dir = unit & 1, bh = unit >> 1, h = bh % NHEAD, b = bh / NHEAD;
        const unsigned char* ch0 = C.CH() + (size_t)(b * NCHUNK * NHEAD + h) * CH_UNIT;
#define DSCAN_DMA(step, slot) do { const int n_ = dir ? NCHUNK - 1 - (step) : (step); const unsigned char* chb_ = ch0 + (size_t)n_ * NHEAD * CH_UNIT; \
        _Pragma("unroll") for (int k_ = 0; k_ < 7; ++k_) { const int pid = (w - 2) * 7 + k_; const int m_ = pid >> 3, pc_ = pid & 7; \
            const unsigned char* src_ = (pid >= 40) ? chb_ + CH_VEC : (m_ < 2 ? chb_ + m_ * 8192 : chb_ + CH_DIR + dir * CH_DIRSZ + (m_ - 2) * 8192) + pc_ * 1024; \
            const int dst_ = (pid >= 40) ? S_VEC : m_ * 8192 + pc_ * 1024; \
            dattn::glds((const bf16*)(src_ + lane * 16), L + (slot) * SLOTB + dst_); } } while (0)
        if (w >= 2) { DSCAN_DMA(0, 0); DSCAN_DMA(1, 1); }
        f32x16 S0, S1;
#pragma unroll
        for (int e = 0; e < 16; ++e) { S0[e] = 0.f; S1[e] = 0.f; }
        bf16x8 sfr[4];
#pragma unroll
        for (int s = 0; s < 4; ++s) sfr[s] = (bf16x8){0, 0, 0, 0, 0, 0, 0, 0};
        bf16* OD = (dir ? C.OB() : C.OF()) + (size_t)b * SEQ * 384 + h * 64 + w * 32 + r32;
        for (int i = 0; i < NCHUNK; ++i) {
            if (w >= 2) asm volatile("s_waitcnt vmcnt(7)" ::: "memory");
            __builtin_amdgcn_s_barrier(); asm volatile("" ::: "memory");
            if (w >= 2) { DSCAN_DMA((i + 2) & (NCHUNK - 1), (i + 2) % 3); }
            else {
                const int n = dir ? NCHUNK - 1 - i : i;
                const LAS unsigned char* B = L + (i % 3) * SLOTB;
                const LAS float* vec = (const LAS float*)(B + S_VEC) + dir * 128;
                f32x16 vn[2];
#pragma unroll
                for (int mt = 0; mt < 2; ++mt) {
                    const LAS unsigned char* up = B + S_UU + ((w * 2 + mt) * 64 + lane) * 32;
                    const v4u u0 = *(const LAS v4u*)up, u1 = *(const LAS v4u*)(up + 16);
                    float f[8]; unpack8(u0, f);
#pragma unroll
                    for (int e = 0; e < 8; ++e) vn[mt][e] = f[e];
                    unpack8(u1, f);
#pragma unroll
                    for (int e = 0; e < 8; ++e) vn[mt][8 + e] = f[e];
#pragma unroll
                    for (int s = 0; s < 4; ++s) { const bf16x8 a = *(const LAS bf16x8*)(B + S_W + (mt * 4 + s) * 1024 + lane * 16); vn[mt] = __builtin_amdgcn_mfma_f32_32x32x16_bf16(a, sfr[s], vn[mt], 0, 0, 0); }
                }
                f32x16 qs[2];
#pragma unroll
                for (int mt = 0; mt < 2; ++mt) {
#pragma unroll
                    for (int e = 0; e < 16; ++e) qs[mt][e] = 0.f;
#pragma unroll
                    for (int s = 0; s < 4; ++s) { const bf16x8 a = *(const LAS bf16x8*)(B + S_QN + (mt * 4 + s) * 1024 + lane * 16); qs[mt] = __builtin_amdgcn_mfma_f32_32x32x16_bf16(a, sfr[s], qs[mt], 0, 0, 0); }
                }
                bf16x8 vfr[4], vsf[4];
#pragma unroll
                for (int mt = 0; mt < 2; ++mt) {
                    vfr[2 * mt] = pack_step(vn[mt], 0); vfr[2 * mt + 1] = pack_step(vn[mt], 1);
                    f32x16 sv;
#pragma unroll
                    for (int g = 0; g < 4; ++g) { const f32x4 ek4 = *(const LAS f32x4*)(vec + 64 + 32 * mt + 8 * g + 4 * hi);
#pragma unroll
                        for (int j = 0; j < 4; ++j) sv[4 * g + j] = vn[mt][4 * g + j] * ek4[j]; }
                    vsf[2 * mt] = pack_step(sv, 0); vsf[2 * mt + 1] = pack_step(sv, 1);
                }
#pragma unroll
                for (int mt = 0; mt < 2; ++mt) {
                    f32x16 av;
#pragma unroll
                    for (int e = 0; e < 16; ++e) av[e] = 0.f;
#pragma unroll
                    for (int s = 0; s < 4; ++s) { const bf16x8 a = *(const LAS bf16x8*)(B + S_AQK + (mt * 4 + s) * 1024 + lane * 16); av = __builtin_amdgcn_mfma_f32_32x32x16_bf16(a, vfr[s], av, 0, 0, 0); }
#pragma unroll
                    for (int g = 0; g < 4; ++g) { const f32x4 eg4 = *(const LAS f32x4*)(vec + 32 * mt + 8 * g + 4 * hi);
#pragma unroll
                        for (int j = 0; j < 4; ++j) { const int c = 32 * mt + 8 * g + 4 * hi + j;
                            OD[(size_t)(n * 64 + c) * 384] = (bf16)f2bf(eg4[j] * qs[mt][4 * g + j] + av[4 * g + j]); } }
                }
                const float egl = dir ? vec[0] : vec[63];
#pragma unroll
                for (int e = 0; e < 16; ++e) { S0[e] *= egl; S1[e] *= egl; }
#pragma unroll
                for (int s = 0; s < 4; ++s) { const bf16x8 a0 = *(const LAS bf16x8*)(B + S_KNT + (0 * 4 + s) * 1024 + lane * 16), a1 = *(const LAS bf16x8*)(B + S_KNT + (1 * 4 + s) * 1024 + lane * 16);
                    S0 = __builtin_amdgcn_mfma_f32_32x32x16_bf16(a0, vsf[s], S0, 0, 0, 0); S1 = __builtin_amdgcn_mfma_f32_32x32x16_bf16(a1, vsf[s], S1, 0, 0, 0); }
                sfr[0] = pack_step(S0, 0); sfr[1] = pack_step(S0, 1); sfr[2] = pack_step(S1, 0); sfr[3] = pack_step(S1, 1);
            }
        }
#undef DSCAN_DMA
        asm volatile("s_waitcnt vmcnt(0)" ::: "memory"); __builtin_amdgcn_s_barrier(); asm volatile("" ::: "memory");
    }
}
namespace dprep {
constexpr int P_KB = 0, P_QB = 9216, P_KF = 18432, P_VF = 35072, P_AF = 51712, P_AB = 68096, P_XS = 84480, P_AQS = 119296, P_GT = 137728, P_END = 139776;
constexpr int KB_LD = 144, XS_LD = 272, AQ_LD = 144;
static_assert(P_AQS + 2 * 64 * AQ_LD == P_GT && P_END <= LDSCTL_OFF && P_XS + 2 * 64 * XS_LD == P_AQS, "prep LDS map");
}
DI void prep_phase(const Ctx& C, int l) {
    using namespace dprep;
    LAS unsigned char* L = C.lds;
    LAS float* kf = (LAS float*)(L + P_KF); LAS float* vf = (LAS float*)(L + P_VF); LAS float* af = (LAS float*)(L + P_AF); LAS float* ab = (LAS float*)(L + P_AB); LAS float* gt = (LAS float*)(L + P_GT);
    const float* dcw = C.in(18) + (size_t)l * 3 * 1152; const float* alog = C.in(19) + l * 12; const float* dtb = C.in(20) + l * 12;
    const int w = C.wave;
    for (int unit = blockIdx.x; unit < NB * NCHUNK * NHEAD; unit += C.G) {
        int tid = C.tid; asm volatile("" : "+v"(tid));
        const int lane = tid & 63, r32 = lane & 31, hi = lane >> 5;
        const int h = unit % NHEAD, bn = unit / NHEAD, n = bn % NCHUNK, b = bn / NCHUNK;
        const size_t t0 = (size_t)b * SEQ + n * 64;
        unsigned char* chb = C.CH() + (size_t)unit * CH_UNIT;
        {   const int c = tid >> 3, d8 = (tid & 7) * 8;
#pragma unroll
            for (int part = 0; part < 3; ++part) {
                const int col = U2_GQ + part * 384 + h * 64 + d8, wch = part * 384 + h * 64 + d8;
                float acc[8];
#pragma unroll
                for (int e = 0; e < 8; ++e) acc[e] = 0.f;
#pragma unroll
                for (int j = 0; j < 3; ++j) { const int p = n * 64 + c + j - 1;
                    if (p >= 0 && p < SEQ) { const v4u r = *(const GAS v4u*)(C.U() + (size_t)(b * SEQ + p) * N2 + col); float f[8]; unpack8(r, f);
#pragma unroll
                        for (int e = 0; e < 8; ++e) acc[e] += dcw[j * 1152 + wch + e] * f[e]; } }
#pragma unroll
                for (int e = 0; e < 8; ++e) acc[e] = siluf_(acc[e]);
                if (part < 2) { float ss = 0.f;
#pragma unroll
                    for (int e = 0; e < 8; ++e) ss += acc[e] * acc[e];
                    ss += xshfl<1>(ss); ss += xshfl<2>(ss); ss += xshfl<4>(ss);
                    const float sc = rsqrtf(ss + 1e-6f) * (part == 0 ? 0.125f : 1.f);
#pragma unroll
                    for (int e = 0; e < 8; ++e) acc[e] *= sc; }
                if (part == 0) *(LAS v4u*)(L + P_QB + c * KB_LD + d8 * 2) = pack8(acc);
                if (part == 1) { *(LAS v4u*)(L + P_KB + c * KB_LD + d8 * 2) = pack8(acc);
#pragma unroll
                    for (int e = 0; e < 8; ++e) kf[c * 65 + d8 + e] = acc[e]; }
                if (part == 2) {
#pragma unroll
                    for (int e = 0; e < 8; ++e) vf[c * 65 + d8 + e] = acc[e]; }
            }
        }
        if (tid < 64) { const int c = tid; const bf16* row = C.U() + (t0 + c) * N2;
            gt[128 + c] = sigmoidf_(bf2f(row[U2_BF + h])); gt[192 + c] = sigmoidf_(bf2f(row[U2_BB + h]));
            gt[c] = -__expf(alog[h]) * softplusf_(bf2f(row[U2_AF + h]) + dtb[h]); gt[64 + c] = -__expf(alog[6 + h]) * softplusf_(bf2f(row[U2_AB + h]) + dtb[6 + h]); }
        __syncthreads();
        if (tid == 0) { float s = 0.f; for (int c = 0; c < 64; ++c) { s += gt[c]; gt[256 + c] = s; gt[384 + c] = __expf(s); } }
        if (tid == 64) { float s = 0.f; for (int c = 63; c >= 0; --c) { s += gt[64 + c]; gt[320 + c] = s; gt[448 + c] = __expf(s); } }
        f32x16 acc;
        const int ti = (w >> 1) & 1, tj = w & 1;
        {
#pragma unroll
            for (int e = 0; e < 16; ++e) acc[e] = 0.f;
            const LAS unsigned char* ap = L + (w < 4 ? P_KB : P_QB) + (32 * ti + r32) * KB_LD + hi * 16; const LAS unsigned char* bp = L + P_KB + (32 * tj + r32) * KB_LD + hi * 16;
#pragma unroll
            for (int s = 0; s < 4; ++s) acc = __builtin_amdgcn_mfma_f32_32x32x16_bf16(*(const LAS bf16x8*)(ap + s * 32), *(const LAS bf16x8*)(bp + s * 32), acc, 0, 0, 0);
        }
        __syncthreads();
        {   const int s = 32 * tj + r32; const float gfs = gt[256 + s], gbs = gt[320 + s];
#pragma unroll
            for (int r = 0; r < 16; ++r) { const int c = 32 * ti + (r & 3) + 8 * (r >> 2) + 4 * hi; const float df = __expf(gt[256 + c] - gfs), db = __expf(gt[320 + c] - gbs);
                if (w < 4) { af[c * 64 + s] = (c > s) ? gt[128 + c] * acc[r] * df : 0.f; ab[(63 - c) * 64 + (63 - s)] = (c < s) ? gt[192 + c] * acc[r] * db : 0.f; }
                else { *(LAS bf16*)(L + P_AQS + c * AQ_LD + s * 2) = (bf16)f2bf((c >= s) ? acc[r] * df : 0.f); *(LAS bf16*)(L + P_AQS + 64 * AQ_LD + c * AQ_LD + s * 2) = (bf16)f2bf((c <= s) ? acc[r] * db : 0.f); } }
        }
        __syncthreads();
        if (w < 4) {
            const int dir = tid >> 7, col = tid & 127;
            unsigned am_a = (unsigned)(uintptr_t)(dir ? ab : af), gt_a = (unsigned)(uintptr_t)gt + dir * 256 + (dir ? 63 * 4 : 0), src_a = (unsigned)(uintptr_t)((col < 64) ? vf + col : kf + (col - 64)) + (dir ? 63 * 65 * 4 : 0);
            unsigned xs_a = (unsigned)(uintptr_t)(L + P_XS + dir * 64 * XS_LD + col * 2) + (dir ? 63 * XS_LD : 0);
            const int gstep = dir ? -4 : 4, sstep = dir ? -65 * 4 : 65 * 4, xstep = dir ? -XS_LD : XS_LD;
            asm volatile("" : "+v"(am_a), "+v"(gt_a), "+v"(src_a), "+v"(xs_a));
#define PL_F(a, off) (*(const LAS float*)(uintptr_t)((a) + (unsigned)(off)))
#define PL_F4(a, off) (*(const LAS f32x4*)(uintptr_t)((a) + (unsigned)(off)))
            float x[64];
#pragma unroll
            for (int i = 0; i < 64; ++i) {
                float a_ = PL_F(gt_a, 128 * 4) * PL_F(src_a, 0); if (col >= 64) a_ *= PL_F(gt_a, 384 * 4);
#pragma unroll
                for (int j4 = 0; j4 < (i + 3) / 4; ++j4) { const f32x4 a4 = PL_F4(am_a, (i * 64 + 4 * j4) * 4);
                    if (4 * j4 + 0 < i) a_ -= a4[0] * x[4 * j4 + 0]; if (4 * j4 + 1 < i) a_ -= a4[1] * x[4 * j4 + 1];
                    if (4 * j4 + 2 < i) a_ -= a4[2] * x[4 * j4 + 2]; if (4 * j4 + 3 < i) a_ -= a4[3] * x[4 * j4 + 3]; }
                x[i] = a_;
                *(LAS bf16*)(uintptr_t)xs_a = (bf16)f2bf(a_);
                gt_a += gstep; src_a += sstep; xs_a += xstep;
                asm volatile("" : "+v"(gt_a), "+v"(src_a), "+v"(xs_a) :: "memory");
            }
#undef PL_F
#undef PL_F4
        } else {
            const int t = tid - 256;
#pragma unroll
            for (int rep = 0; rep < 2; ++rep) { const int sl = t + 256 * rep, row = sl >> 3, s = (sl >> 1) & 3, hh = sl & 1;
                typedef unsigned u32x2_t __attribute__((ext_vector_type(2)));
                const int dst = ((row >> 5) * 4 + s) * 1024 + (hh * 32 + (row & 31)) * 16;
                {   const u32x2_t a = *(const LAS u32x2_t*)(L + P_QB + row * KB_LD + (16 * s + 4 * hh) * 2), b2 = *(const LAS u32x2_t*)(L + P_QB + row * KB_LD + (16 * s + 8 + 4 * hh) * 2);
                    *(GAS v4u*)(chb + CH_QN + dst) = (v4u){a.x, a.y, b2.x, b2.y}; }
                {   unsigned e[8];
#pragma unroll
                    for (int j = 0; j < 8; ++j) { const int cc = 16 * s + 8 * (j >> 2) + 4 * hh + (j & 3); e[j] = *(const LAS bf16*)(L + P_KB + cc * KB_LD + row * 2); }
                    *(GAS v4u*)(chb + CH_KNT + dst) = (v4u){e[0] | (e[1] << 16), e[2] | (e[3] << 16), e[4] | (e[5] << 16), e[6] | (e[7] << 16)}; }
#pragma unroll
                for (int dir = 0; dir < 2; ++dir) { const LAS unsigned char* q = L + P_AQS + dir * 64 * AQ_LD + row * AQ_LD;
                    const u32x2_t a = *(const LAS u32x2_t*)(q + (16 * s + 4 * hh) * 2), b2 = *(const LAS u32x2_t*)(q + (16 * s + 8 + 4 * hh) * 2);
                    *(GAS v4u*)(chb + CH_DIR + dir * CH_DIRSZ + CH_AQK + dst) = (v4u){a.x, a.y, b2.x, b2.y}; }
            }
            if (t < 128) { const int dir = t >> 6, c = t & 63; const float gl = dir ? gt[320] : gt[256 + 63]; float* vec = (float*)(chb + CH_VEC + dir * 512); vec[c] = gt[384 + 64 * dir + c]; vec[64 + c] = __expf(gl - gt[256 + 64 * dir + c]); }
        }
        __syncthreads();
        {   const int dir = tid >> 8, sl = (tid >> 7) & 1, mt = (tid >> 6) & 1, ln = tid & 63, hh = ln >> 5, dv = 32 * sl + (ln & 31);
            const LAS unsigned char* xs = L + P_XS + dir * 64 * XS_LD + dv * 2; unsigned e[16];
#pragma unroll
            for (int r = 0; r < 16; ++r) { const int c = 32 * mt + (r & 3) + 8 * (r >> 2) + 4 * hh; e[r] = *(const LAS bf16*)(xs + c * XS_LD); }
            unsigned char* dst = chb + CH_DIR + dir * CH_DIRSZ + CH_UU + ((sl * 2 + mt) * 64 + ln) * 32;
            *(GAS v4u*)dst = (v4u){e[0] | (e[1] << 16), e[2] | (e[3] << 16), e[4] | (e[5] << 16), e[6] | (e[7] << 16)};
            *(GAS v4u*)(dst + 16) = (v4u){e[8] | (e[9] << 16), e[10] | (e[11] << 16), e[12] | (e[13] << 16), e[14] | (e[15] << 16)};
        }
#pragma unroll
        for (int rep = 0; rep < 2; ++rep) { const int sl = tid + 512 * rep, dir = sl >> 9, row = (sl >> 3) & 63, s = (sl >> 1) & 3, hh = sl & 1;
            typedef unsigned u32x2_t __attribute__((ext_vector_type(2)));
            const LAS unsigned char* q = L + P_XS + dir * 64 * XS_LD + row * XS_LD + 128;
            const u32x2_t a = *(const LAS u32x2_t*)(q + (16 * s + 4 * hh) * 2), b2 = *(const LAS u32x2_t*)(q + (16 * s + 8 + 4 * hh) * 2);
            *(GAS v4u*)(chb + CH_DIR + dir * CH_DIRSZ + CH_W + ((row >> 5) * 4 + s) * 1024 + (hh * 32 + (row & 31)) * 16) = (v4u){a.x ^ 0x80008000u, a.y ^ 0x80008000u, b2.x ^ 0x80008000u, b2.y ^ 0x80008000u}; }
        __syncthreads();
    }
}
constexpr int PH_PER_LAYER = 11, NPH = 1 + PH_PER_LAYER * DEPTH;
__global__ void __launch_bounds__(NTHREADS, 2) mega(Args args) {
    extern __shared__ __attribute__((aligned(16))) unsigned char lds_raw[];
    Ctx C;
    C.lds = (LAS unsigned char*)lds_raw;
    C.tid = threadIdx.x; C.lane = C.tid & 63; C.wave = __builtin_amdgcn_readfirstlane(C.tid >> 6);
    C.G = gridDim.x; C.gw = blockIdx.x * NWAVES + C.wave; C.NGW = C.G * NWAVES;
    C.a = &args;
    for (int u = C.tid; u < (LDS_BYTES - LDSCTL_OFF) / 4; u += NTHREADS) ((LAS unsigned*)(C.lds + LDSCTL_OFF))[u] = 0u;
    __syncthreads();
#if MK_SINGLE
    volatile LAS unsigned* MISC = (volatile LAS unsigned*)(C.lds + MISC_OFF);
    XcdBarrier bar = xcd_barrier_post((unsigned*)((gu32*)(C.ws() + WS_CTL) + CW_BAR), MISC + 8);
    cg::grid_group grid = cg::this_grid();
#endif
    for (int p = args.ph_lo; p < args.ph_hi; ++p) {
        { int t_ = threadIdx.x; asm volatile("" : "+v"(t_)); C.tid = t_; C.lane = t_ & 63; }
        if (p == 0) {
#ifndef DIS_ROW
            rowwise(C, nullptr, C.in(0), C.out(), nullptr, C.in(3), C.YH());
#endif
#ifndef DIS_CVT
            convert_layer(C, 0);
#endif
        } else {
            const int l = (p - 1) / PH_PER_LAYER, k = (p - 1) % PH_PER_LAYER;
            if (k == 0) {
#if USE_PG8 == 2
#elif USE_PG8
                pg8::Gemm g{C.YH(), C.Win2(), M_TOK, N2, DM}; pg8::StaticOrder S; S.init(M_TOK, N2, C.G, (int)blockIdx.x);
                pg8::EpiBf16<0> E{C.U(), N2};
                pg8::gemm_phase<pg8::EpiBf16<0>, pg8::StaticOrder, true, true>(C.lds, g, S, E);
#else
                gemm_simple<0>(C, C.YH(), C.Win2(), N2, DM, C.U(), N2);
#endif
            } else if (k == 2) {
#if USE_PG8 == 2
#elif USE_PG8
                pg8::Gemm g{C.YH(), C.Win1(), M_TOK, N1, DM}; pg8::StaticOrder S; S.init(M_TOK, N1, C.G, (int)blockIdx.x);
                pg8::EpiBf16<0> E{C.U(), N1};
                pg8::gemm_phase<pg8::EpiBf16<0>, pg8::StaticOrder, true, true>(C.lds, g, S, E);
#else
                gemm_simple<0>(C, C.YH(), C.Win1(), N1, DM, C.U(), N1);
#endif
            } else if (k == 1) {
#ifndef DIS_PREP
#if PREP_SIMPLE
                delta_prep(C, l);
#else
                prep_phase(C, l);
#endif
#endif
            } else if (k == 3) {
#ifndef DIS_CONV
                conv_phase(C, l);
#endif
#ifndef DIS_ATTN
#if ATTN_SIMPLE
                attn_simple(C, l);
#else
                attn_phase(C, l);
#endif
#endif
            } else if (k == 4) {
#ifndef DIS_SCAN
                scan_phase(C);
#endif
            } else if (k == 5) {
#ifndef DIS_FIN
                delta_finish(C, l);
#endif
            } else if (k == 6) {
#if USE_PG8 == 2
#elif USE_PG8
                pg8::Gemm g{C.YH(), C.Wout(), M_TOK, DM, DM}; pg8::StaticOrder S; S.init(M_TOK, DM, C.G, (int)blockIdx.x);
                pg8::EpiF32 E{C.T(), DM};
                pg8::gemm_phase<pg8::EpiF32, pg8::StaticOrder, true, true>(C.lds, g, S, E);
#else
                gemm_simple<2>(C, C.YH(), C.Wout(), DM, DM, C.T(), DM);
#endif
            } else if (k == 9) {
#if USE_PG8 == 2
#elif USE_PG8
                pg8::Gemm g{C.HID(), C.Wff2(), M_TOK, DM, FF}; pg8::StaticOrder S; S.init(M_TOK, DM, C.G, (int)blockIdx.x);
                pg8::EpiF32 E{C.T(), DM};
                pg8::gemm_phase<pg8::EpiF32, pg8::StaticOrder, true, true>(C.lds, g, S, E);
#else
                gemm_simple<2>(C, C.HID(), C.Wff2(), DM, FF, C.T(), DM);
#endif
            } else if (k == 7) {
#ifndef DIS_ROW
                rowwise(C, C.T(), C.out(), C.out(), C.in(4) + l * DM, C.in(5) + l * DM, C.YH());
#endif
            } else if (k == 8) {
#if USE_PG8 == 2
#elif USE_PG8
                pg8::Gemm g{C.YH(), C.Wff1(), M_TOK, FF, DM}; pg8::StaticOrder S; S.init(M_TOK, FF, C.G, (int)blockIdx.x);
                pg8::EpiBf16<1> E{C.HID(), FF};
                pg8::gemm_phase<pg8::EpiBf16<1>, pg8::StaticOrder, true, true>(C.lds, g, S, E);
#else
                gemm_simple<1>(C, C.YH(), C.Wff1(), FF, DM, C.HID(), FF);
#endif
            } else {
#ifndef DIS_ROW
                rowwise(C, C.T(), C.out(), C.out(), C.in(6) + l * DM, (l + 1 < DEPTH) ? C.in(3) + (l + 1) * DM : nullptr, C.YH());
#endif
#ifndef DIS_CVT
                if (l + 1 < DEPTH) convert_layer(C, l + 1);
#endif
            }
        }
#if MK_SINGLE
        if (p + 1 < args.ph_hi) { if (p == 0) grid.sync(); else xcd_barrier(bar); }
#else
        __syncthreads();
#endif
    }
}

extern "C" void kernel_launch(void* const* d_in, const int* in_sizes, int n_in, void* d_out, int out_size, void* d_ws, size_t ws_size, hipStream_t stream) {
    static int grid = 0;
    if (grid == 0) {
        if (n_in != 22 || in_sizes[0] != M_TOK * DM || out_size != M_TOK * DM || ws_size < WS_END) {
            fprintf(stderr, "kernel_launch: unexpected problem: n_in %d in0 %d out %d ws %zu (need >= %zu)\n", n_in, n_in > 0 ? in_sizes[0] : -1, out_size, ws_size, (size_t)WS_END); grid = -1; return; }
        int dev = 0, cus = 0, per_cu = 0;
        if (hipGetDevice(&dev) != hipSuccess || hipDeviceGetAttribute(&cus, hipDeviceAttributeMultiprocessorCount, dev) != hipSuccess) { fprintf(stderr, "kernel_launch: device query failed\n"); grid = -1; return; }
        if (hipFuncSetAttribute((const void*)mega, hipFuncAttributeMaxDynamicSharedMemorySize, LDS_BYTES) != hipSuccess) { fprintf(stderr, "kernel_launch: hipFuncSetAttribute failed\n"); grid = -1; return; }
        if (hipOccupancyMaxActiveBlocksPerMultiprocessor(&per_cu, (const void*)mega, NTHREADS, LDS_BYTES) != hipSuccess || per_cu < 1) { fprintf(stderr, "kernel_launch: occupancy query says %d blocks per CU\n", per_cu); per_cu = 1; }
        (void)hipGetLastError();
        grid = cus;
        if (grid != 256) fprintf(stderr, "kernel_launch: note: %d CUs\n", grid);
    }
    if (grid < 0) return;
    if (hipMemsetAsync((char*)d_ws + WS_CTL, 0, CTL_ZERO_BYTES, stream) != hipSuccess) { fprintf(stderr, "kernel_launch: memset failed\n"); return; }
    Args a{};
    for (int i = 0; i < 22; ++i) a.in[i] = (const float*)d_in[i];
    a.out = (float*)d_out; a.ws = (unsigned char*)d_ws;
#if MK_SINGLE
    a.ph_lo = 0; a.ph_hi = NPH;
    void* kargs[] = {&a};
    const hipError_t e = hipLaunchCooperativeKernel((const void*)mega, dim3(grid), dim3(NTHREADS), kargs, LDS_BYTES, stream);
    if (e != hipSuccess) fprintf(stderr, "kernel_launch: cooperative launch failed: %s (grid %d)\n", hipGetErrorString(e), grid);
#else
    for (int p = 0; p < NPH; ++p) {
        a.ph_lo = p; a.ph_hi = p + 1;
        hipLaunchKernelGGL(mega, dim3(grid), dim3(NTHREADS), LDS_BYTES, stream, a);
        const hipError_t le = hipPeekAtLastError();
        if (le != hipSuccess) { fprintf(stderr, "kernel_launch: launch %d failed: %s\n", p, hipGetErrorName(le)); break; }
    }
#endif
}
```
